# Optimizing an MI355X kernel written in HIP

```python
import numpy as np
import jax, jax.numpy as jnp
from jax import lax

D_MODEL = 1024
BATCH = 32
SEQ = 2048
DEPTH = 2

HEAD_DIM = 64
MOBA_HEADS = D_MODEL // (2 * HEAD_DIM)
NSA_HEADS = D_MODEL // (2 * HEAD_DIM)
NSA_KV_GROUPS = 2
NSA_HPG = NSA_HEADS // NSA_KV_GROUPS
MOBA_BLOCK = 256
MOBA_TOPK = 3
CMP_LEN = 32
CMP_STRIDE = 16
SLC_BLOCK = 64
SLC_TOPN = 16
WINDOW = 512
Q_CHUNK = 128
RMS_EPS = 1e-6
NEG = -1e9
FORCE_BONUS = 1e4

MOBA_W = MOBA_HEADS * HEAD_DIM
NSA_W = NSA_HEADS * HEAD_DIM
KV_W = NSA_KV_GROUPS * HEAD_DIM
SPLITS = [MOBA_W] * 4 + [NSA_W] + [KV_W] * 6 + [3 * NSA_HEADS] + [NSA_W]
D_IN = sum(SPLITS)

kernel_name = "hybrid_moba_nsa_sandwich_adaln"


def rmsnorm(x, g):
    xf = x.astype(jnp.float32)
    y = xf * lax.rsqrt(jnp.mean(xf * xf, axis=-1, keepdims=True) + RMS_EPS)
    return (y * g.astype(jnp.float32)).astype(x.dtype)


def alibi_slopes(n):
    return jnp.asarray(2.0 ** (-8.0 * np.arange(1, n + 1) / n), dtype=jnp.float32)


def cmp_to_slc_matrix(n_cmp, n_slc):
    i = np.arange(n_cmp)[:, None]
    j = np.arange(n_slc)[None, :]
    start = i * CMP_STRIDE
    end = start + CMP_LEN
    ov = (start < (j + 1) * SLC_BLOCK) & (end > j * SLC_BLOCK)
    return jnp.asarray(ov.astype(np.float32))


def compress_blocks(k, pe, w1, w2):
    B, S, G, dh = k.shape
    T = (S - CMP_LEN) // CMP_STRIDE + 1
    idx = np.arange(T)[:, None] * CMP_STRIDE + np.arange(CMP_LEN)[None, :]
    win = k[:, idx] + pe[:, None, :]
    win = win.transpose(0, 3, 1, 2, 4).reshape(B, G, T, CMP_LEN * dh)
    return jax.nn.gelu(win @ w1) @ w2


def hybrid_mixer(h, w_in, w_out, pe_k, pe_v, w_ck1, w_ck2, w_cv1, w_cv2):
    B, S, _ = h.shape
    dh = HEAD_DIM
    NC = S // Q_CHUNK
    NB = -(-S // MOBA_BLOCK)
    KM = min(MOBA_TOPK, NB)
    NBS = S // SLC_BLOCK
    NS = min(SLC_TOPN, NBS)
    T = (S - CMP_LEN) // CMP_STRIDE + 1
    scale = dh ** -0.5

    u = h @ w_in
    offs = np.cumsum(SPLITS)[:-1].tolist()
    (qm, km, vm, zm, qn, kc, vc, ks, vs, kw, vw, gl, zn) = jnp.split(u, offs, axis=-1)

    def heads(a, n):
        return a.reshape(B, S, n, dh).transpose(0, 2, 1, 3)

    pad = NB * MOBA_BLOCK - S
    qm = heads(qm, MOBA_HEADS) * scale
    km = jnp.pad(heads(km, MOBA_HEADS), ((0, 0), (0, 0), (0, pad), (0, 0))).reshape(B, MOBA_HEADS, NB, MOBA_BLOCK, dh)
    vm = jnp.pad(heads(vm, MOBA_HEADS), ((0, 0), (0, 0), (0, pad), (0, 0))).reshape(B, MOBA_HEADS, NB, MOBA_BLOCK, dh)
    kmean = jnp.mean(km, axis=3)

    G = NSA_KV_GROUPS
    qn = qn.reshape(B, S, G, NSA_HPG, dh).transpose(0, 2, 3, 1, 4) * scale
    kc = compress_blocks(kc.reshape(B, S, G, dh), pe_k, w_ck1, w_ck2)
    vc = compress_blocks(vc.reshape(B, S, G, dh), pe_v, w_cv1, w_cv2)
    ks = heads(ks, G).reshape(B, G, NBS, SLC_BLOCK, dh)
    vs = heads(vs, G).reshape(B, G, NBS, SLC_BLOCK, dh)
    kw = jnp.pad(heads(kw, G), ((0, 0), (0, 0), (WINDOW, 0), (0, 0)))
    vw = jnp.pad(heads(vw, G), ((0, 0), (0, 0), (WINDOW, 0), (0, 0)))
    gates = jax.nn.sigmoid(gl.astype(jnp.float32)).reshape(B, S, G, NSA_HPG, 3)

    slope_m = alibi_slopes(MOBA_HEADS)
    slope_n = alibi_slopes(NSA_HEADS).reshape(G, NSA_HPG)
    M = cmp_to_slc_matrix(T, NBS)
    hidx = jnp.arange(MOBA_HEADS)[:, None, None]
    gidx = jnp.arange(G)[:, None, None]

    def chunk(i):
        b = i // NC
        s0 = (i % NC) * Q_CHUNK
        t = s0 + jnp.arange(Q_CHUNK)
        take = lambda a: lax.dynamic_index_in_dim(a, b, 0, keepdims=False)

        q = lax.dynamic_slice_in_dim(take(qm), s0, Q_CHUNK, axis=1)
        Kb, Vb, Kmean = take(km), take(vm), take(kmean)
        cur = s0 // MOBA_BLOCK
        gsc = jnp.einsum('hqd,hnd->hqn', q, Kmean).astype(jnp.float32)
        gsc = jnp.where(jnp.arange(NB) < cur, gsc, NEG)
        _, sel = lax.top_k(gsc, KM)
        sel_ok = jnp.arange(KM) < cur
        k_sel = Kb[hidx, sel]
        v_sel = Vb[hidx, sel]
        s_sel = jnp.einsum('hqd,hqkbd->hqkb', q, k_sel).astype(jnp.float32)
        pos_sel = sel[..., None] * MOBA_BLOCK + jnp.arange(MOBA_BLOCK)
        d_sel = (t[None, :, None, None] - pos_sel).astype(jnp.float32)
        s_sel = jnp.where(sel_ok[None, None, :, None], s_sel - slope_m[:, None, None, None] * d_sel, NEG)
        k_own = lax.dynamic_index_in_dim(Kb, cur, 1, keepdims=False)
        v_own = lax.dynamic_index_in_dim(Vb, cur, 1, keepdims=False)
        s_own = jnp.einsum('hqd,hkd->hqk', q, k_own).astype(jnp.float32)
        d_own = t[:, None] - (cur * MOBA_BLOCK + jnp.arange(MOBA_BLOCK))[None, :]
        s_own = jnp.where(d_own >= 0, s_own - slope_m[:, None, None] * d_own.astype(jnp.float32), NEG)
        logits = jnp.concatenate([s_sel.reshape(MOBA_HEADS, Q_CHUNK, KM * MOBA_BLOCK), s_own], axis=-1)
        p = jax.nn.softmax(logits, axis=-1).astype(v_own.dtype)
        p_sel = p[..., :KM * MOBA_BLOCK].reshape(MOBA_HEADS, Q_CHUNK, KM, MOBA_BLOCK)
        o_m = (jnp.einsum('hqkb,hqkbd->hqd', p_sel, v_sel)
               + jnp.einsum('hqb,hbd->hqd', p[..., KM * MOBA_BLOCK:], v_own))
        o_m = o_m.transpose(1, 0, 2).reshape(Q_CHUNK, MOBA_W)

        qg = lax.dynamic_slice_in_dim(take(qn), s0, Q_CHUNK, axis=2)
        kcb, vcb = take(kc), take(vc)
        s_c = jnp.einsum('gjqd,gtd->gjqt', qg, kcb).astype(jnp.float32)
        d_c = t[:, None] - (jnp.arange(T) * CMP_STRIDE + CMP_LEN - 1)[None, :]
        ok_c = d_c >= 0
        s_c = jnp.where(ok_c, s_c - slope_n[:, :, None, None] * d_c.astype(jnp.float32), NEG)
        p_c = jax.nn.softmax(s_c, axis=-1) * ok_c
        o_c = jnp.einsum('gjqt,gtd->gjqd', p_c.astype(vcb.dtype), vcb)
        imp = jnp.einsum('gjqt,tn->gqn', p_c, M)
        blk = t // SLC_BLOCK
        jn = jnp.arange(NBS)[None, :]
        forced = (jn == 0) | (jn == blk[:, None]) | (jn == blk[:, None] - 1)
        imp = jnp.where(forced, FORCE_BONUS, imp)
        imp = jnp.where(jn <= blk[:, None], imp, NEG)
        _, sidx = lax.top_k(imp, NS)
        s_valid = sidx <= blk[None, :, None]
        ksb = take(ks)[gidx, sidx]
        vsb = take(vs)[gidx, sidx]
        s_s = jnp.einsum('gjqd,gqnbd->gjqnb', qg, ksb).astype(jnp.float32)
        d_s = t[None, :, None, None] - (sidx[..., None] * SLC_BLOCK + jnp.arange(SLC_BLOCK))
        ok_s = (d_s >= 0) & s_valid[..., None]
        s_s = jnp.where(ok_s[:, None], s_s - slope_n[:, :, None, None, None] * d_s[:, None].astype(jnp.float32), NEG)
        p_s = jax.nn.softmax(s_s.reshape(G, NSA_HPG, Q_CHUNK, NS * SLC_BLOCK), axis=-1)
        p_s = p_s.reshape(G, NSA_HPG, Q_CHUNK, NS, SLC_BLOCK).astype(vsb.dtype)
        o_s = jnp.einsum('gjqnb,gqnbd->gjqd', p_s, vsb)
        kwb = lax.dynamic_slice_in_dim(take(kw), s0, WINDOW + Q_CHUNK, axis=1)
        vwb = lax.dynamic_slice_in_dim(take(vw), s0, WINDOW + Q_CHUNK, axis=1)
        s_w = jnp.einsum('gjqd,gkd->gjqk', qg, kwb).astype(jnp.float32)
        pos_w = s0 - WINDOW + jnp.arange(WINDOW + Q_CHUNK)
        d_w = t[:, None] - pos_w[None, :]
        ok_w = (d_w >= 0) & (d_w < WINDOW) & (pos_w >= 0)[None, :]
        s_w = jnp.where(ok_w, s_w - slope_n[:, :, None, None] * d_w.astype(jnp.float32), NEG)
        p_w = jax.nn.softmax(s_w, axis=-1).astype(vwb.dtype)
        o_w = jnp.einsum('gjqk,gkd->gjqd', p_w, vwb)
        g = lax.dynamic_slice_in_dim(take(gates), s0, Q_CHUNK, axis=0).transpose(1, 2, 0, 3)
        g = g.astype(o_c.dtype)
        o_n = g[..., 0:1] * o_c + g[..., 1:2] * o_s + g[..., 2:3] * o_w
        o_n = o_n.transpose(2, 0, 1, 3).reshape(Q_CHUNK, NSA_W)
        return o_m, o_n

    o_m, o_n = lax.map(chunk, jnp.arange(B * NC))
    o_m = o_m.reshape(B, S, MOBA_W)
    o_n = o_n.reshape(B, S, NSA_W)
    y = jnp.concatenate([o_m * jax.nn.silu(zm), o_n * jax.nn.silu(zn)], axis=-1)
    return y @ w_out


def setup_inputs(seed: int = 0) -> dict:
    key = jax.random.key(seed)
    ks = jax.random.split(key, 16)
    L, D, dh = DEPTH, D_MODEL, HEAD_DIM
    nrm = lambda k, shape, s: jax.random.normal(k, shape, jnp.float32) * s
    return {
        "x": nrm(ks[0], (BATCH, SEQ, D), 1.0),
        "c": nrm(ks[1], (BATCH, D), 1.0),
        "w_ada": nrm(ks[2], (L, D, 3 * D), D ** -0.5),
        "b_ada": nrm(ks[3], (L, 3 * D), 0.01),
        "g_pre": 1.0 + nrm(ks[4], (L, D), 0.1),
        "g_post": 1.0 + nrm(ks[5], (L, D), 0.1),
        "w_in": nrm(ks[6], (L, D, D_IN), D ** -0.5),
        "w_out": nrm(ks[7], (L, D, D), D ** -0.5),
        "pe_k": nrm(ks[8], (L, CMP_LEN, dh), 0.1),
        "pe_v": nrm(ks[9], (L, CMP_LEN, dh), 0.1),
        "w_ck1": nrm(ks[10], (L, CMP_LEN * dh, dh), (CMP_LEN * dh) ** -0.5),
        "w_ck2": nrm(ks[11], (L, dh, dh), dh ** -0.5),
        "w_cv1": nrm(ks[12], (L, CMP_LEN * dh, dh), (CMP_LEN * dh) ** -0.5),
        "w_cv2": nrm(ks[13], (L, dh, dh), dh ** -0.5),
    }


def reference(x, c, w_ada, b_ada, g_pre, g_post, w_in, w_out, pe_k, pe_v, w_ck1, w_ck2, w_cv1, w_cv2):
    D = x.shape[-1]
    cs = jax.nn.silu(c)
    for l in range(DEPTH):
        mod = cs @ w_ada[l] + b_ada[l]
        shift, scale, gate = mod[:, None, :D], mod[:, None, D:2 * D], mod[:, None, 2 * D:]
        h = rmsnorm(x, g_pre[l]) * (1.0 + scale) + shift
        y = hybrid_mixer(h, w_in[l], w_out[l], pe_k[l], pe_v[l], w_ck1[l], w_ck2[l], w_cv1[l], w_cv2[l])
        x = x + gate * rmsnorm(y, g_post[l])
    return x
```

```cpp
#include <hip/hip_runtime.h>
#include <hip/hip_cooperative_groups.h>
#include <hip/hip_bf16.h>
#include <cstdio>
#include <cstdint>
#include <cmath>
namespace cg = cooperative_groups;
namespace pg8 {
#define PG8_LAS __attribute__((address_space(3)))
typedef unsigned short bf16_t;
typedef short bf16x8 __attribute__((ext_vector_type(8)));
typedef float f32x4 __attribute__((ext_vector_type(4)));
typedef unsigned u32x4 __attribute__((ext_vector_type(4)));
constexpr int BM = 256, BK = 64, HALF = 128, HTB = HALF * BK * 2  , STAGE_BYTES = 8 * HTB, NXCD = 8, WGM = 8;

__host__ __device__ __forceinline__ int lds_byte(int r, int c) { const int st = (r >> 4) * 2 + (c >> 5), rr = r & 15, cc = c & 31, ob = rr * 64 + cc * 2; return st * 1024 + (ob ^ (((ob >> 9) & 1) << 5)); }
__host__ __device__ __forceinline__ void stage_rc(int b, int& R, int& C) { const int st = b / 1024, sb = b % 1024, swz = sb ^ (((sb >> 9) & 1) << 5); R = (st >> 1) * 16 + swz / 64; C = (st & 1) * 32 + (swz % 64) / 2; }
__host__ __device__ __forceinline__ int perm32(int rho) { const int n = rho >> 4, i = rho & 15; return 8 * (i >> 2) + 4 * n + (i & 3); }

struct Unit { int pm, pn; };
struct Gemm { const bf16_t* A; const bf16_t* Bt; int M, N, K; };

struct StaticOrder {
    int nM, nN, nwg, G, c;
    __host__ __device__ void init(int M, int N, int G_, int c_) { nM = M / BM; nN = N / BM; nwg = nM * nN; G = G_; c = c_; }
    __host__ __device__ bool next(int i, Unit& u) const {
        const long L = (long)i * G + c; if (L >= nwg) return false;
        int wgid = (int)L; { const int q = nwg / NXCD, r = nwg % NXCD, xcd = wgid % NXCD, off = wgid / NXCD; wgid = (xcd < r ? xcd * (q + 1) : r * (q + 1) + (xcd - r) * q) + off; }
        const int nig = WGM * nN, gid = wgid / nig, fm = gid * WGM, gsz = (nM - fm) < WGM ? (nM - fm) : WGM;
        u.pm = fm + ((wgid % nig) % gsz); u.pn = (wgid % nig) / gsz; return true;
    }
    __device__ __forceinline__ void a_ready(const Unit&) const {}
    __device__ __forceinline__ void done(const Unit&) const {}
};
template <int NN>
struct GroupOrder {
    int b, j;
    __host__ __device__ void init(int b_, int j_) { b = b_; j = j_; }
    __host__ __device__ bool next(int i, Unit& u) const { const int t = 8 * i + j; if (t >= 8 * NN) return false; u.pm = 8 * b + t / NN; u.pn = t % NN; return true; }
    __device__ __forceinline__ void a_ready(const Unit&) const {}
    __device__ __forceinline__ void done(const Unit&) const {}
};
template <int NN>
struct OwnerOrder {
    int b, j;
    __host__ __device__ void init(int b_, int j_) { b = b_; j = j_; }
    __host__ __device__ bool next(int i, Unit& u) const { if (i >= NN) return false; u.pm = 8 * b + j; u.pn = i; return true; }
    __device__ __forceinline__ void a_ready(const Unit&) const {}
    __device__ __forceinline__ void done(const Unit&) const {}
};
__device__ __forceinline__ unsigned cvt_pk_bf16(float lo, float hi) { unsigned r; asm volatile("v_cvt_pk_bf16_f32 %0, %1, %2" : "=v"(r) : "v"(lo), "v"(hi)); return r; }
struct EpiStore {
    static constexpr bool PERM = true, AFTER_DRAIN = false, ZEROES = true;
    bf16_t* O; int ldc; int ncols;
    __device__ __forceinline__ void operator()(f32x4 (&acc)[2][2][4][2], const Unit& u, int wr, int wc, int fr, int fq) const {
        const int row0 = u.pm * BM + wr * 64 + fr; const int col0 = u.pn * BM + wc * 32 + 8 * fq;
#pragma unroll
        for (int ai = 0; ai < 2; ++ai)
#pragma unroll
            for (int m = 0; m < 4; ++m) { bf16_t* rowp = O + (size_t)(row0 + ai * HALF + m * 16) * ldc + col0;
#pragma unroll
                for (int bj = 0; bj < 2; ++bj) { const f32x4 v0 = acc[ai][bj][m][0], v1 = acc[ai][bj][m][1];
                    u32x4 w; w.x = cvt_pk_bf16(v0[0], v0[1]); w.y = cvt_pk_bf16(v0[2], v0[3]); w.z = cvt_pk_bf16(v1[0], v1[1]); w.w = cvt_pk_bf16(v1[2], v1[3]);
                    if (col0 + bj * HALF < ncols) *(u32x4*)(rowp + bj * HALF) = w;
                    acc[ai][bj][m][0] = (f32x4){0.f, 0.f, 0.f, 0.f}; acc[ai][bj][m][1] = (f32x4){0.f, 0.f, 0.f, 0.f}; __builtin_amdgcn_sched_barrier(0); } }
    }
};

struct EpiStoreG {
    static constexpr bool PERM = true, AFTER_DRAIN = false, ZEROES = false;
    bf16_t* O; int M; int ncols;
    __device__ __forceinline__ void operator()(const f32x4 (&acc)[2][2][4][2], const Unit& u, int wr, int wc, int fr, int fq) const {
        const int row0 = u.pm * BM + wr * 64 + fr; const int col0 = u.pn * BM + wc * 32 + 8 * fq;
#pragma unroll
        for (int bj = 0; bj < 2; ++bj) { const int col = col0 + bj * HALF; bf16_t* cp = O + ((size_t)(col >> 6) * M + row0) * 64 + (col & 63);
            if (col < ncols) {
#pragma unroll
                for (int ai = 0; ai < 2; ++ai)
#pragma unroll
                    for (int m = 0; m < 4; ++m) { const f32x4 v0 = acc[ai][bj][m][0], v1 = acc[ai][bj][m][1];
                        u32x4 w; w.x = cvt_pk_bf16(v0[0], v0[1]); w.y = cvt_pk_bf16(v0[2], v0[3]); w.z = cvt_pk_bf16(v1[0], v1[1]); w.w = cvt_pk_bf16(v1[2], v1[3]);
                        *(u32x4*)(cp + (size_t)(ai * HALF + m * 16) * 64) = w; } } }
    }
};

__device__ __forceinline__ float row16_sum(float v) {
    v += __builtin_bit_cast(float, __builtin_amdgcn_update_dpp(0, __builtin_bit_cast(int, v), 0xB1, 0xF, 0xF, true));
    v += __builtin_bit_cast(float, __builtin_amdgcn_update_dpp(0, __builtin_bit_cast(int, v), 0x4E, 0xF, 0xF, true));
    v += __builtin_bit_cast(float, __builtin_amdgcn_update_dpp(0, __builtin_bit_cast(int, v), 0x141, 0xF, 0xF, true));
    v += __builtin_bit_cast(float, __builtin_amdgcn_update_dpp(0, __builtin_bit_cast(int, v), 0x140, 0xF, 0xF, true));
    return v;
}
struct EpiStoreGK {
    static constexpr bool PERM = true, AFTER_DRAIN = false, ZEROES = true;
    bf16_t* O; int M; int ncols; float* KM;
    __device__ __forceinline__ void operator()(f32x4 (&acc)[2][2][4][2], const Unit& u, int wr, int wc, int fr, int fq) const {
        const int row0 = u.pm * BM + wr * 64 + fr; const int col0 = u.pn * BM + wc * 32 + 8 * fq;
        if ((u.pn >> 1) == 1) {
            float* kmb = KM + (size_t)(((u.pm >> 3) * 8) * 8 + (u.pm & 7)) * 64;
#pragma unroll
            for (int bj = 0; bj < 2; ++bj) { const int kcol = col0 + bj * HALF - 512;
                float* dst = kmb + (size_t)(kcol >> 6) * 512 + (kcol & 63);
#pragma unroll
                for (int h2 = 0; h2 < 2; ++h2)
#pragma unroll
                    for (int e = 0; e < 4; ++e) { float s = 0.f;
#pragma unroll
                        for (int ai = 0; ai < 2; ++ai)
#pragma unroll
                            for (int m = 0; m < 4; ++m) s += acc[ai][bj][m][h2][e];
                        s = row16_sum(s);
                        if (fr == 0) atomicAdd(dst + 4 * h2 + e, s); } }
        }
#pragma unroll
        for (int bj = 0; bj < 2; ++bj) { const int col = col0 + bj * HALF; bf16_t* cp = O + ((size_t)(col >> 6) * M + row0) * 64 + (col & 63);
#pragma unroll
            for (int ai = 0; ai < 2; ++ai)
#pragma unroll
                for (int m = 0; m < 4; ++m) { const f32x4 v0 = acc[ai][bj][m][0], v1 = acc[ai][bj][m][1];
                    u32x4 w; w.x = cvt_pk_bf16(v0[0], v0[1]); w.y = cvt_pk_bf16(v0[2], v0[3]); w.z = cvt_pk_bf16(v1[0], v1[1]); w.w = cvt_pk_bf16(v1[2], v1[3]);
                    if (col < ncols) *(u32x4*)(cp + (size_t)(ai * HALF + m * 16) * 64) = w;
                    acc[ai][bj][m][0] = (f32x4){0.f, 0.f, 0.f, 0.f}; acc[ai][bj][m][1] = (f32x4){0.f, 0.f, 0.f, 0.f}; __builtin_amdgcn_sched_barrier(0); } }
    }
};

template <class Epi, class Sched, bool ALIGN_EPI = false, bool SP2 = false>
__device__ __forceinline__ void gemm_phase(PG8_LAS unsigned char* lds, const Gemm g, const Sched& S, const Epi& E, const int tid) {
    const int wid = __builtin_amdgcn_readfirstlane(tid >> 6), lane = tid & 63, wr = wid >> 2, wc = wid & 3, fr = lane & 15, fq = lane >> 4;
    const int K = g.K, nt = K / BK;
    unsigned voffA[2], voffB[2];
#pragma unroll
    for (int i = 0; i < 2; ++i) { int R, C; stage_rc(tid * 16 + i * 8192, R, C); const int Rb = Epi::PERM ? ((R & ~31) + perm32(R & 31)) : R;
        voffA[i] = (unsigned)(R * K + C) * 2u; voffB[i] = (unsigned)(Rb * K + C) * 2u; }
    const size_t kstep = (size_t)(BK * 2);
    const size_t hstep = (size_t)HALF * K * 2;
    const size_t tstep = 2 * hstep;
    const unsigned ldsw = (unsigned)wid * 1024u;
    const int aoff = lds_byte(wr * 64 + fr, fq * 8), boff = lds_byte(wc * 32 + fr, fq * 8);
#define PG8_SA(b, h) (((b) * 2 + (h)) * HTB)
#define PG8_SB(b, h) ((4 + (b) * 2 + (h)) * HTB)
#define PG8_STAGE(bufoff, gbase, voff) do { _Pragma("unroll") for (int _i = 0; _i < 2; ++_i) \
        __builtin_amdgcn_global_load_lds((const unsigned*)((const char*)(gbase) + (voff)[_i]), (PG8_LAS unsigned*)(lds + (bufoff) + ldsw + _i * 8192), 16, 0, 0); } while (0)
#define PG8_LDA(dst, b, h) do { _Pragma("unroll") for (int m = 0; m < 4; ++m) _Pragma("unroll") for (int k = 0; k < 2; ++k) dst[m][k] = *(const PG8_LAS bf16x8*)(lds + PG8_SA(b, h) + aoff + m * 2048 + k * 1024); } while (0)
#define PG8_LDB(dst, b, h) do { _Pragma("unroll") for (int n = 0; n < 2; ++n) _Pragma("unroll") for (int k = 0; k < 2; ++k) dst[n][k] = *(const PG8_LAS bf16x8*)(lds + PG8_SB(b, h) + boff + n * 2048 + k * 1024); } while (0)
#define PG8_MMA(ai, bj, At, Bt) do { __builtin_amdgcn_s_setprio(1); _Pragma("unroll") for (int m = 0; m < 4; ++m) _Pragma("unroll") for (int n = 0; n < 2; ++n) _Pragma("unroll") for (int k = 0; k < 2; ++k) \
        acc[ai][bj][m][n] = __builtin_amdgcn_mfma_f32_16x16x32_bf16(Bt[n][k], At[m][k], acc[ai][bj][m][n], 0, 0, 0); __builtin_amdgcn_s_setprio(0); } while (0)
#define PG8_WAIT_V(n) asm volatile("s_waitcnt vmcnt(" #n ")" ::: "memory")
#define PG8_WAIT_L(n) asm volatile("s_waitcnt lgkmcnt(" #n ")" ::: "memory")
#define PG8_BAR __builtin_amdgcn_s_barrier()
#define PG8_SCHED __builtin_amdgcn_sched_barrier(0)
    Unit cur, nxt; int ui = 0;
    if (!S.next(0, cur)) return;
    f32x4 acc[2][2][4][2];
#pragma unroll
    for (int a = 0; a < 2; ++a)
#pragma unroll
        for (int b = 0; b < 2; ++b)
#pragma unroll
            for (int m = 0; m < 4; ++m)
#pragma unroll
                for (int n = 0; n < 2; ++n) acc[a][b][m][n] = (f32x4){0.f, 0.f, 0.f, 0.f};
    bf16x8 At[4][2], B0[2][2], B1[2][2];
    const char* cA = (const char*)g.A + (size_t)cur.pm * tstep; const char* cB = (const char*)g.Bt + (size_t)cur.pn * tstep;
    S.a_ready(cur);
    if constexpr (SP2) {
        PG8_STAGE(PG8_SB(0, 0), cB, voffB); PG8_STAGE(PG8_SB(0, 1), cB + hstep, voffB); PG8_STAGE(PG8_SA(0, 0), cA, voffA); PG8_STAGE(PG8_SA(0, 1), cA + hstep, voffA);
        if (wr == 1) PG8_BAR;
        PG8_WAIT_V(2); PG8_BAR;
        PG8_STAGE(PG8_SB(1, 0), cB + kstep, voffB); PG8_STAGE(PG8_SA(1, 0), cA + kstep, voffA); PG8_STAGE(PG8_SB(1, 1), cB + hstep + kstep, voffB);
        PG8_WAIT_V(6); PG8_BAR;
    } else {
        PG8_STAGE(PG8_SB(0, 0), cB, voffB); PG8_STAGE(PG8_SA(0, 0), cA, voffA); PG8_STAGE(PG8_SB(0, 1), cB + hstep, voffB); PG8_STAGE(PG8_SA(0, 1), cA + hstep, voffA);
        if (wr == 1) PG8_BAR;
        PG8_WAIT_V(4); PG8_BAR;
        PG8_STAGE(PG8_SB(1, 0), cB + kstep, voffB); PG8_STAGE(PG8_SA(1, 0), cA + kstep, voffA); PG8_STAGE(PG8_SB(1, 1), cB + hstep + kstep, voffB);
        PG8_WAIT_V(6); PG8_BAR;
    }
    for (;;) {
        const bool has_next = S.next(ui + 1, nxt);
        const char* nA = has_next ? (const char*)g.A + (size_t)nxt.pm * tstep : cA; const char* nB = has_next ? (const char*)g.Bt + (size_t)nxt.pn * tstep : cB;
        for (int t = 0; t < nt; t += 2) {
            const bool last = (t == nt - 2);
            const char* a1 = cA + (size_t)(t + 1) * kstep;
            const char* a2 = last ? nA : cA + (size_t)(t + 2) * kstep; const char* b2 = last ? nB : cB + (size_t)(t + 2) * kstep;
            const char* a3 = a2 + kstep; const char* b3 = b2 + kstep;
            if (last && has_next) S.a_ready(nxt);
            if constexpr (SP2) {
            int uio_ = ui; asm volatile("" : "+s"(uio_));
            int tz_ = t; asm volatile("" : "+s"(tz_));
            const bool after_epi = (tz_ == 0) && (uio_ > 0);
            PG8_LDB(B0, 0, 0); PG8_LDB(B1, 0, 1); PG8_SCHED; PG8_LDA(At, 0, 0); PG8_STAGE(PG8_SA(1, 1), a1 + hstep, voffA);
            if (after_epi) PG8_WAIT_V(24); else PG8_WAIT_V(8);
            PG8_WAIT_L(0); PG8_BAR; PG8_MMA(0, 0, At, B0); PG8_MMA(0, 1, At, B1); PG8_BAR; PG8_SCHED;
            PG8_LDA(At, 0, 1); PG8_STAGE(PG8_SB(0, 0), b2, voffB); PG8_STAGE(PG8_SB(0, 1), b2 + hstep, voffB); PG8_STAGE(PG8_SA(0, 0), a2, voffA);
            if (after_epi) PG8_WAIT_V(24); else PG8_WAIT_V(8);
            PG8_WAIT_L(0); PG8_BAR; PG8_MMA(1, 0, At, B0); PG8_MMA(1, 1, At, B1); PG8_BAR; PG8_SCHED;
            PG8_LDB(B0, 1, 0); PG8_LDB(B1, 1, 1); PG8_SCHED; PG8_LDA(At, 1, 0); PG8_STAGE(PG8_SA(0, 1), a2 + hstep, voffA);
            PG8_WAIT_V(8); PG8_WAIT_L(0); PG8_BAR; PG8_MMA(0, 0, At, B0); PG8_MMA(0, 1, At, B1); PG8_BAR; PG8_SCHED;
            PG8_LDA(At, 1, 1); PG8_STAGE(PG8_SB(1, 0), b3, voffB); PG8_STAGE(PG8_SB(1, 1), b3 + hstep, voffB); PG8_STAGE(PG8_SA(1, 0), a3, voffA);
            PG8_WAIT_V(8); PG8_WAIT_L(0); PG8_BAR; PG8_MMA(1, 0, At, B0); PG8_MMA(1, 1, At, B1); PG8_BAR; PG8_SCHED;
            } else {
            PG8_LDB(B0, 0, 0); PG8_SCHED; PG8_LDA(At, 0, 0); PG8_STAGE(PG8_SA(1, 1), a1 + hstep, voffA);
            PG8_WAIT_L(8); PG8_BAR; PG8_WAIT_L(0); PG8_MMA(0, 0, At, B0); PG8_BAR; PG8_SCHED;
            PG8_LDB(B1, 0, 1); PG8_STAGE(PG8_SB(0, 0), b2, voffB);
            PG8_BAR; PG8_WAIT_L(0); PG8_MMA(0, 1, At, B1); PG8_BAR;
            PG8_LDA(At, 0, 1); PG8_STAGE(PG8_SA(0, 0), a2, voffA);
            PG8_BAR; PG8_WAIT_L(0); PG8_MMA(1, 0, At, B0); PG8_BAR; PG8_SCHED;
            PG8_STAGE(PG8_SB(0, 1), b2 + hstep, voffB);
            PG8_WAIT_V(6); PG8_BAR; PG8_MMA(1, 1, At, B1); PG8_BAR;
            PG8_LDB(B0, 1, 0); PG8_SCHED; PG8_LDA(At, 1, 0); PG8_STAGE(PG8_SA(0, 1), a2 + hstep, voffA);
            PG8_WAIT_L(8); PG8_BAR; PG8_WAIT_L(0); PG8_MMA(0, 0, At, B0); PG8_BAR; PG8_SCHED;
            PG8_LDB(B1, 1, 1); PG8_STAGE(PG8_SB(1, 0), b3, voffB);
            PG8_BAR; PG8_WAIT_L(0); PG8_MMA(0, 1, At, B1); PG8_BAR;
            PG8_LDA(At, 1, 1); PG8_STAGE(PG8_SA(1, 0), a3, voffA);
            PG8_BAR; PG8_WAIT_L(0); PG8_MMA(1, 0, At, B0); PG8_BAR; PG8_SCHED;
            PG8_STAGE(PG8_SB(1, 1), b3 + hstep, voffB);
            PG8_WAIT_V(6); PG8_BAR; PG8_MMA(1, 1, At, B1); PG8_BAR;
            }
        }
        if constexpr (ALIGN_EPI) { if (wr == 0) PG8_BAR; }
        if constexpr (!Epi::AFTER_DRAIN) { E(acc, cur, wr, wc, fr, fq); S.done(cur); }
        if (!has_next) break;
        if constexpr (!Epi::ZEROES)
#pragma unroll
        for (int a = 0; a < 2; ++a)
#pragma unroll
            for (int b = 0; b < 2; ++b)
#pragma unroll
                for (int m = 0; m < 4; ++m)
#pragma unroll
                    for (int n = 0; n < 2; ++n) acc[a][b][m][n] = (f32x4){0.f, 0.f, 0.f, 0.f};
        cur = nxt; cA = nA; cB = nB; ++ui;
        if constexpr (ALIGN_EPI) { if (wr == 1) PG8_BAR; }
    }
    PG8_WAIT_V(0);
    if constexpr (!ALIGN_EPI) { if (wr == 0) PG8_BAR; }
    PG8_BAR;
    if constexpr (Epi::AFTER_DRAIN) { E.fused(acc, cur, wr, wc, fr, fq, lds, wid, lane); S.done(cur); }
#undef PG8_SA
#undef PG8_SB
#undef PG8_STAGE
#undef PG8_LDA
#undef PG8_LDB
#undef PG8_MMA
#undef PG8_WAIT_V
#undef PG8_WAIT_L
#undef PG8_BAR
#undef PG8_SCHED
}
}
namespace att {
using bf16x8 = __attribute__((ext_vector_type(8))) short;
using s16x4 = __attribute__((ext_vector_type(4))) short;
using f32x16 = __attribute__((ext_vector_type(16))) float;
using u32x4 = __attribute__((ext_vector_type(4))) unsigned;
typedef unsigned short bf16_t;
#define ALAS __attribute__((address_space(3)))
typedef ALAS const char* lds_cptr;
typedef short v4i16_t __attribute__((ext_vector_type(4)));
constexpr int UP = 64;
constexpr int MR = 65536;
constexpr int YP = 1024;
constexpr int SEQ = 2048;
constexpr int SLOTB = 8192;
constexpr int RD = 3, KA = RD + 2, VA = RD + 1, NKS = KA + 1, NVS = VA + 1;
constexpr int LDS_K = 0, LDS_V = NKS * SLOTB, LDS_WS = (NKS + NVS) * SLOTB, LDS_RM = LDS_WS + 8 * 256, LDS_WQ = LDS_RM + 256, LDS_OST = LDS_WQ + 256, LDS_IMP = LDS_OST + 8 * 4096, LDS_END = LDS_IMP + 4 * 64 * 33 * 4;
static_assert(LDS_IMP + 4 * 64 * 33 * 4 >= LDS_OST + 8 * 8192, "per-wave park region");
constexpr int LDS_TAB = LDS_END;
static_assert(LDS_TAB + 56 * 16 <= 163840 - 256, "step table below the frame's last 256 bytes");
constexpr float LOG2E = 1.4426950408889634f;
constexpr float THR = 6.0f;
constexpr float NEGINF = -INFINITY;
constexpr int C_QM = 0, C_KM = 512, C_VM = 1024, C_ZM = 1536, C_QN = 2048, C_KC = 2560, C_VC = 2688, C_KS = 2816, C_VS = 2944, C_KW = 3072, C_VW = 3200, C_ZN = 3328, C_GL = 3840;

__device__ __forceinline__ const unsigned short* ucol(const unsigned short* U, int col) { return U + (size_t)(col >> 6) * MR * 64 + (col & 63); }
__device__ __forceinline__ int crow(int r, int hi) { return (r & 3) + 8 * (r >> 2) + 4 * hi; }
__device__ __forceinline__ float bf2f(bf16_t v) { return __uint_as_float((unsigned)v << 16); }
__device__ __forceinline__ void glds16(const void* gsrc, unsigned lds_dst) { unsigned keep;
  asm volatile("s_mov_b32 %0, m0\n\ts_mov_b32 m0, %2\n\ts_nop 0\n\tglobal_load_lds_dwordx4 %1, off\n\ts_mov_b32 m0, %0" : "=&s"(keep) : "v"(gsrc), "s"(lds_dst) : "memory"); }
typedef float f32x2_t __attribute__((ext_vector_type(2))); typedef __bf16 bf16x2_t __attribute__((ext_vector_type(2)));
__device__ __forceinline__ unsigned cvtpk(float lo, float hi) { f32x2_t v = {lo, hi}; bf16x2_t b = __builtin_convertvector(v, bf16x2_t); return __builtin_bit_cast(unsigned, b); }
#define AT_WAIT_BAR() asm volatile("s_waitcnt vmcnt(0) lgkmcnt(0)\n\ts_barrier" ::: "memory")
#define AT_SBAR() __builtin_amdgcn_sched_barrier(0)
struct KAddr { lds_cptr a[4]; };
__device__ __forceinline__ void kload8(bf16x8* kf, const KAddr& ka, int slotoff) {
#pragma unroll
  for (int d0 = 0; d0 < 4; ++d0) { kf[2 * d0] = *(const ALAS bf16x8*)(ka.a[d0] + slotoff); kf[2 * d0 + 1] = *(const ALAS bf16x8*)(ka.a[d0] + slotoff + 4096); }
}
__device__ __forceinline__ void qkt(f32x16& p0, f32x16& p1, const KAddr& ka, int slotoff, const bf16x8* qr) {
  bf16x8 kf[8]; kload8(kf, ka, slotoff);
  p0 = f32x16{}; p1 = f32x16{};
#pragma unroll
  for (int d0 = 0; d0 < 4; ++d0) {
    p0 = __builtin_amdgcn_mfma_f32_32x32x16_bf16(kf[2 * d0], qr[d0], p0, 0, 0, 0);
    p1 = __builtin_amdgcn_mfma_f32_32x32x16_bf16(kf[2 * d0 + 1], qr[d0], p1, 0, 0, 0);
  }
}
__device__ __forceinline__ float rowmax32(const f32x16& p0, const f32x16& p1) {
  float a = fmaxf(p0[0], p1[0]);
#pragma unroll
  for (int r = 1; r < 16; ++r) a = fmaxf(a, fmaxf(p0[r], p1[r]));
  return fmaxf(a, __shfl_xor(a, 32));
}
__device__ __forceinline__ void pv(f32x16* o, int vb, bf16x8 pa0, bf16x8 pa1, bf16x8 pa2, bf16x8 pa3) {
#pragma unroll
  for (int d0 = 0; d0 < 2; ++d0) { s16x4 lo[4], hi[4];
#pragma unroll
    for (int ks = 0; ks < 4; ++ks) {
      asm volatile("ds_read_b64_tr_b16 %0,%1 offset:%c2" : "=&v"(lo[ks]) : "v"(vb), "i"(d0 * 4096 + ks * 1024) : "memory");
      asm volatile("ds_read_b64_tr_b16 %0,%1 offset:%c2" : "=&v"(hi[ks]) : "v"(vb), "i"(d0 * 4096 + ks * 1024 + 512) : "memory"); }
    asm volatile("s_waitcnt lgkmcnt(0)" ::: "memory"); AT_SBAR();
#define AT_PK(k) (bf16x8){lo[k][0], lo[k][1], lo[k][2], lo[k][3], hi[k][0], hi[k][1], hi[k][2], hi[k][3]}
    o[d0] = __builtin_amdgcn_mfma_f32_32x32x16_bf16(pa0, AT_PK(0), o[d0], 0, 0, 0);
    o[d0] = __builtin_amdgcn_mfma_f32_32x32x16_bf16(pa1, AT_PK(1), o[d0], 0, 0, 0);
    o[d0] = __builtin_amdgcn_mfma_f32_32x32x16_bf16(pa2, AT_PK(2), o[d0], 0, 0, 0);
    o[d0] = __builtin_amdgcn_mfma_f32_32x32x16_bf16(pa3, AT_PK(3), o[d0], 0, 0, 0);
#undef AT_PK
  }
}
__device__ __forceinline__ void pack_p(const f32x16& p0, const f32x16& p1, float s, bf16x8& a0, bf16x8& a1, bf16x8& a2, bf16x8& a3) {
  u32x4 w0 = {cvtpk(p0[0] * s, p0[1] * s), cvtpk(p0[2] * s, p0[3] * s), cvtpk(p0[4] * s, p0[5] * s), cvtpk(p0[6] * s, p0[7] * s)};
  u32x4 w1 = {cvtpk(p0[8] * s, p0[9] * s), cvtpk(p0[10] * s, p0[11] * s), cvtpk(p0[12] * s, p0[13] * s), cvtpk(p0[14] * s, p0[15] * s)};
  u32x4 w2 = {cvtpk(p1[0] * s, p1[1] * s), cvtpk(p1[2] * s, p1[3] * s), cvtpk(p1[4] * s, p1[5] * s), cvtpk(p1[6] * s, p1[7] * s)};
  u32x4 w3 = {cvtpk(p1[8] * s, p1[9] * s), cvtpk(p1[10] * s, p1[11] * s), cvtpk(p1[12] * s, p1[13] * s), cvtpk(p1[14] * s, p1[15] * s)};
  a0 = __builtin_bit_cast(bf16x8, w0); a1 = __builtin_bit_cast(bf16x8, w1); a2 = __builtin_bit_cast(bf16x8, w2); a3 = __builtin_bit_cast(bf16x8, w3);
}
__device__ __forceinline__ void pack_p1(const f32x16& p0, const f32x16& p1, bf16x8& a0, bf16x8& a1, bf16x8& a2, bf16x8& a3) {
  u32x4 w0 = {cvtpk(p0[0], p0[1]), cvtpk(p0[2], p0[3]), cvtpk(p0[4], p0[5]), cvtpk(p0[6], p0[7])};
  u32x4 w1 = {cvtpk(p0[8], p0[9]), cvtpk(p0[10], p0[11]), cvtpk(p0[12], p0[13]), cvtpk(p0[14], p0[15])};
  u32x4 w2 = {cvtpk(p1[0], p1[1]), cvtpk(p1[2], p1[3]), cvtpk(p1[4], p1[5]), cvtpk(p1[6], p1[7])};
  u32x4 w3 = {cvtpk(p1[8], p1[9]), cvtpk(p1[10], p1[11]), cvtpk(p1[12], p1[13]), cvtpk(p1[14], p1[15])};
  a0 = __builtin_bit_cast(bf16x8, w0); a1 = __builtin_bit_cast(bf16x8, w1); a2 = __builtin_bit_cast(bf16x8, w2); a3 = __builtin_bit_cast(bf16x8, w3);
}

struct Ctx {
  char* shm; unsigned lds0; int lane, r32, hi, wid;
  KAddr ka; int vb0; float* wsf;
  int koff, voff;
};
__device__ __forceinline__ void dma_tile(const Ctx& c, const bf16_t* Kb, const bf16_t* Vb, int pitch, int krow0, int slot) {
  const int krow = 8 * c.wid + (c.lane >> 3); const bf16_t* ks = Kb + (size_t)(krow0 + krow) * pitch + (((c.lane & 7) ^ ((krow >> 1) & 7)) << 3);
  const bf16_t* vs = Vb + (size_t)(krow0 + 16 * (c.wid & 3) + (c.lane >> 2)) * pitch + (c.wid >> 2) * 32 + (c.lane & 3) * 8;
  glds16(ks, (unsigned)__builtin_amdgcn_readfirstlane(c.lds0 + LDS_K + slot * SLOTB + c.wid * 1024));
  glds16(vs, (unsigned)__builtin_amdgcn_readfirstlane(c.lds0 + LDS_V + slot * SLOTB + c.wid * 1024));
}

__device__ __forceinline__ void dma_k(const Ctx& c, const bf16_t* Kb, int pitch, int krow0, int slot) {
  const int krow = 8 * c.wid + (c.lane >> 3);
  glds16(Kb + (size_t)(krow0 + krow) * pitch + (((c.lane & 7) ^ ((krow >> 1) & 7)) << 3), (unsigned)__builtin_amdgcn_readfirstlane(c.lds0 + LDS_K + slot * SLOTB + c.wid * 1024)); }
__device__ __forceinline__ void dma_v(const Ctx& c, const bf16_t* Vb, int pitch, int krow0, int slot) {
  const int vrow = 8 * c.wid + (c.lane >> 3), jp = c.lane & 7, j = ((((jp >> 1) ^ (((vrow >> 1) & 1) << 1)) << 1) | (jp & 1));
  glds16(Vb + (size_t)(krow0 + vrow) * pitch + j * 8, (unsigned)__builtin_amdgcn_readfirstlane(c.lds0 + LDS_V + slot * SLOTB + c.wid * 1024)); }
__device__ __forceinline__ void dma_k_off(const Ctx& c, const bf16_t* U, int off, int slot) {
  glds16((const char*)U + (long)off + c.koff, (unsigned)__builtin_amdgcn_readfirstlane(c.lds0 + LDS_K + slot * SLOTB + c.wid * 1024)); }
__device__ __forceinline__ void dma_v_off(const Ctx& c, const bf16_t* U, int off, int slot) {
  glds16((const char*)U + (long)off + c.voff, (unsigned)__builtin_amdgcn_readfirstlane(c.lds0 + LDS_V + slot * SLOTB + c.wid * 1024)); }
__device__ __forceinline__ float max3f(float a, float b, float c) { float r; asm("v_max3_f32 %0, %1, %2, %3" : "=v"(r) : "v"(a), "v"(b), "v"(c)); return r; }
__device__ __forceinline__ float max_halves(float a) { auto rr = __builtin_amdgcn_permlane32_swap(__float_as_uint(a), __float_as_uint(a), false, false); return fmaxf(__uint_as_float(rr[0]), __uint_as_float(rr[1])); }
__device__ __forceinline__ float sum_halves(float a) { auto rr = __builtin_amdgcn_permlane32_swap(__float_as_uint(a), __float_as_uint(a), false, false); return __uint_as_float(rr[0]) + __uint_as_float(rr[1]); }
__device__ __forceinline__ s16x4 vtr(lds_cptr p) { return __builtin_bit_cast(s16x4, __builtin_amdgcn_ds_read_tr16_b64_v4i16((ALAS v4i16_t*)p)); }

__device__ __forceinline__ void wait_bar_n(int n) {
  if (n >= 6) asm volatile("s_waitcnt vmcnt(6) lgkmcnt(0)\n\ts_barrier" ::: "memory");
  else if (n == 5) asm volatile("s_waitcnt vmcnt(5) lgkmcnt(0)\n\ts_barrier" ::: "memory");
  else if (n == 4) asm volatile("s_waitcnt vmcnt(4) lgkmcnt(0)\n\ts_barrier" ::: "memory");
  else if (n == 3) asm volatile("s_waitcnt vmcnt(3) lgkmcnt(0)\n\ts_barrier" ::: "memory");
  else if (n == 2) asm volatile("s_waitcnt vmcnt(2) lgkmcnt(0)\n\ts_barrier" ::: "memory");
  else if (n == 1) asm volatile("s_waitcnt vmcnt(1) lgkmcnt(0)\n\ts_barrier" ::: "memory");
  else asm volatile("s_waitcnt vmcnt(0) lgkmcnt(0)\n\ts_barrier" ::: "memory");
}
struct UnitP { int type, qi, n, nts; const bf16_t *k0, *k1, *k2;
  int npre; unsigned pre; unsigned remk, remv, remc;
  int ncmp; };
__device__ __forceinline__ int pop_lo(unsigned& m) { const int t = __builtin_ctz(m); m &= m - 1u; return t; }
constexpr long DV_M = (long)8 * MR * 64;
constexpr long DV_N = (long)2 * MR * 64;
constexpr long DV_C = 524288;
__device__ __forceinline__ void esrc(UnitP& u, int s, int which  , const bf16_t*& kp, const bf16_t*& vp, bool& hasv) {
  hasv = true;
  if (u.type == 0) {
    if (s == 0) { kp = u.k0; vp = u.k0; hasv = false; }
    else { const int tile = s < 5 ? 4 * u.qi + (s - 1) : s - 5; kp = u.k1 + (size_t)tile * 4096; vp = kp + DV_M; }
  } else {
    if (s < u.ncmp) { kp = u.k0 + s * 4096; vp = kp + DV_C; }
    else { const int j = s - u.ncmp;
      if (j < u.nts) { const int tile = (j < u.npre) ? (int)((u.pre >> (5 * j)) & 31u) : pop_lo(which == 0 ? u.remk : u.remv); kp = u.k1 + (size_t)tile * 4096; vp = kp + DV_N; }
      else { const int tile = u.qi - (j - u.nts); kp = u.k2 + (size_t)tile * 4096; vp = kp + DV_N; } }
  }
}
struct Ring { int ks, vs, c1, c2, pw; };
__device__ __forceinline__ int issue_pair(const Ctx& c, UnitP& u, int ek, int sk, int ev, int sv) {
  int cnt = 0; const bf16_t *kp, *vp; bool hv;
  if (ek < u.n) { esrc(u, ek, 0, kp, vp, hv); dma_k(c, kp, UP, 0, sk); ++cnt; }
  if (ev < u.n) { esrc(u, ev, 1, kp, vp, hv); if (hv) { dma_v(c, vp, UP, 0, sv); ++cnt; } }
  return cnt;
}
__device__ __forceinline__ void prologue_issue(const Ctx& c, UnitP& u, Ring& rg) {
  const bf16_t *kp, *vp; bool hv;
  esrc(u, 0, 0, kp, vp, hv); dma_k(c, kp, UP, 0, 0); if (hv) dma_v(c, vp, UP, 0, 0);
  if (u.n > 1) { esrc(u, 1, 0, kp, vp, hv); dma_k(c, kp, UP, 0, 1); }
  const int ca = issue_pair(c, u, 2, 2, 1, 1), cb = issue_pair(c, u, 3, 3, 2, 2), cc = issue_pair(c, u, 4, 4, 3, 3);
  rg.ks = 0; rg.vs = 0; rg.c1 = cc; rg.c2 = cb; rg.pw = ca + cb + cc;
}
__device__ __forceinline__ void prologue_wait(const Ctx& c, bf16x8* kf, const Ring& rg) {
  const int n = rg.pw + 8;
  if (n >= 14) asm volatile("s_waitcnt vmcnt(14) lgkmcnt(0)\n\ts_barrier" ::: "memory");
  else if (n >= 12) asm volatile("s_waitcnt vmcnt(12) lgkmcnt(0)\n\ts_barrier" ::: "memory");
  else if (n >= 10) asm volatile("s_waitcnt vmcnt(10) lgkmcnt(0)\n\ts_barrier" ::: "memory");
  else asm volatile("s_waitcnt vmcnt(8) lgkmcnt(0)\n\ts_barrier" ::: "memory");
  kload8(kf, c.ka, 0);
}
__device__ __forceinline__ void make_unit(UnitP& u, int type, int b, int hg, int qi, const bf16_t* U, const bf16_t* KMHL, const bf16_t* KC) {
  const size_t rowbase = (size_t)b * SEQ; u.type = type; u.qi = qi;
  if (type == 0) { u.n = 5 + 4 * qi; u.nts = 0; u.k0 = KMHL + (size_t)((b * 8 + hg) * 16) * 64; u.k1 = ucol(U, C_KM + hg * 64) + rowbase * UP; u.k2 = u.k1; }
  u.npre = 0; u.pre = 0u; u.remk = 0u; u.remv = 0u; u.remc = 0u; u.ncmp = 0;
  if (type != 0) {
    unsigned have = 0u, pk = 0u; int np = 0;
#define AT_PRE(t_) do { const int tt_ = (t_); if (tt_ >= 0) { if (!((have >> tt_) & 1u)) { have |= 1u << tt_; pk |= (unsigned)tt_ << (5 * np); ++np; } } } while (0)
    AT_PRE(qi); AT_PRE(qi - 1); AT_PRE(0); AT_PRE(qi - 2); AT_PRE(qi - 3);
#undef AT_PRE
    u.npre = np; u.pre = pk;
    const int nts = qi + 1, ntw = (qi < 8 ? qi : 8) + 1; u.ncmp = (qi < 16) ? 1 : 2; u.n = u.ncmp + nts + ntw; u.nts = nts;
    u.k0 = KC + (size_t)((b * 2 + hg) * 128) * 64; u.k1 = ucol(U, C_KS + hg * 64) + rowbase * UP; u.k2 = ucol(U, C_KW + hg * 64) + rowbase * UP;
  }
}
__device__ __forceinline__ const bf16_t* q_row(const Ctx& c, int type, int b, int hg, int qi, const bf16_t* U) {
  if (type == 0) return ucol(U, C_QM + hg * 64) + ((size_t)b * SEQ + 256 * qi + 32 * c.wid + c.r32) * UP;
  return ucol(U, C_QN + (hg * 4 + (c.wid >> 1)) * 64) + ((size_t)b * SEQ + 64 * qi + 32 * (c.wid & 1) + c.r32) * UP;
}
__device__ __forceinline__ int step_top(const Ctx& c, UnitP& u, int s, const Ring& rg) {
  return issue_pair(c, u, s + KA, rg.ks == 0 ? NKS - 1 : rg.ks - 1, s + VA, rg.vs == 0 ? NVS - 1 : rg.vs - 1);
}
__device__ __forceinline__ int next_k(const UnitP& u, int s, const Ring& rg) { (void)u; (void)s; return ((rg.ks + 1 == NKS) ? 0 : rg.ks + 1) * SLOTB; }
__device__ __forceinline__ void step_end(const Ctx& c, const UnitP& u, int s, int cnt, bf16x8* kf, Ring& rg, bool load = true) {
  __builtin_amdgcn_sched_barrier(0);
  const int ks1 = (rg.ks + 1 == NKS) ? 0 : rg.ks + 1;
  if (load && s + 1 < u.n) kload8(kf, c.ka, ks1 * SLOTB);
  wait_bar_n(cnt + rg.c1 + rg.c2);
  rg.c2 = rg.c1; rg.c1 = cnt; rg.ks = ks1; rg.vs = (rg.vs + 1 == NVS) ? 0 : rg.vs + 1;
}

template <int KST>
__device__ __forceinline__ void att_tile(const Ctx& c, int vs, bf16x8* kf, int knext  , const bf16x8* qr, float sk, float t0, int mode, int qx,
                                         float& m, float& l, f32x16* o, f32x16& p0, f32x16& p1) {
  const int vq = (c.lane & 15) >> 2, vx = (vq >> 1) & 1;
  const lds_cptr vpb = (lds_cptr)c.shm + LDS_V + vs * SLOTB + (4 * c.hi + vq) * 128 + ((c.lane >> 4) & 1) * 32 + (c.lane & 3) * 8;
  const lds_cptr vp0 = vpb + vx * 64, vp1 = vpb + (1 - vx) * 64;
  s16x4 vlo[8], vhi[8];
#pragma unroll
  for (int x = 0; x < 4; ++x) { vlo[x] = vtr(vp0 + x * 2048); vhi[x] = vtr(vp0 + x * 2048 + 1024); vlo[4 + x] = vtr(vp1 + x * 2048); vhi[4 + x] = vtr(vp1 + x * 2048 + 1024); }
  { typedef float f32x2v_ __attribute__((ext_vector_type(2)));
    const float sk8 = sk * 8.f, s32 = sk * 32.f; const f32x2v_ P01 = {0.f, sk}, P23 = {sk + sk, sk * 3.f};
    float bg = t0 - m;
#pragma unroll
    for (int g4 = 0; g4 < 4; ++g4) { const float bh = bg + s32;
      const f32x2v_ a_ = P01 + bg, b_ = P23 + bg, c_ = P01 + bh, d_ = P23 + bh;
      p0[4 * g4] = a_.x; p0[4 * g4 + 1] = a_.y; p0[4 * g4 + 2] = b_.x; p0[4 * g4 + 3] = b_.y;
      p1[4 * g4] = c_.x; p1[4 * g4 + 1] = c_.y; p1[4 * g4 + 2] = d_.x; p1[4 * g4 + 3] = d_.y;
      bg += sk8; } }
#pragma unroll
  for (int d0 = 0; d0 < 4; ++d0) {
    p0 = __builtin_amdgcn_mfma_f32_32x32x16_bf16(kf[2 * d0], qr[d0], p0, 0, 0, 0);
    p1 = __builtin_amdgcn_mfma_f32_32x32x16_bf16(kf[2 * d0 + 1], qr[d0], p1, 0, 0, 0);
  }
  kload8(kf, c.ka, knext);
  if (mode != 0) {
    if (mode == 1) {
#pragma unroll
      for (int r = 0; r < 16; ++r) { const int kc = KST * ((r & 3) + 8 * (r >> 2)); if (kc > qx) p0[r] = NEGINF; if (kc + 32 * KST > qx) p1[r] = NEGINF; }
    } else {
#pragma unroll
      for (int r = 0; r < 16; ++r) { const int kc = (r & 3) + 8 * (r >> 2); if (kc <= qx) p0[r] = NEGINF; if (kc + 32 <= qx) p1[r] = NEGINF; }
    }
  }
  asm volatile("s_nop 15\n\ts_nop 7" : "+v"(p0), "+v"(p1));
  float rm = max3f(p0[0], p1[0], p0[1]), rm2 = max3f(p1[1], p0[2], p1[2]);
#pragma unroll
  for (int r = 3; r < 15; r += 2) { rm = max3f(rm, p0[r], p1[r]); rm2 = max3f(rm2, p0[r + 1], p1[r + 1]); }
  rm = max3f(rm, rm2, p0[15]); rm = max3f(rm, p1[15], rm);
  rm = max_halves(rm);
  if (__any(rm > THR)) {
    const float dl = fmaxf(rm, 0.f); m += dl;
#pragma unroll
    for (int r = 0; r < 16; ++r) { p0[r] -= dl; p1[r] -= dl; }
    const float alpha = __builtin_amdgcn_exp2f(-dl); l *= alpha;
    if (c.hi == 0) c.wsf[c.r32] = alpha;
    asm volatile("s_waitcnt lgkmcnt(0)" ::: "memory");
#pragma unroll
    for (int r = 0; r < 16; ++r) { const float f = c.wsf[crow(r, c.hi)]; o[0][r] *= f; o[1][r] *= f; }
    asm volatile("s_waitcnt lgkmcnt(0)" ::: "memory");
  }
  float s = 0.f;
#pragma unroll
  for (int r = 0; r < 16; ++r) { p0[r] = __builtin_amdgcn_exp2f(p0[r]); p1[r] = __builtin_amdgcn_exp2f(p1[r]); s += p0[r] + p1[r]; }
  l += s;
  bf16x8 a0, a1, a2, a3; pack_p1(p0, p1, a0, a1, a2, a3);
#define AT_VFR(x) (bf16x8){vlo[x][0], vlo[x][1], vlo[x][2], vlo[x][3], vhi[x][0], vhi[x][1], vhi[x][2], vhi[x][3]}
  o[0] = __builtin_amdgcn_mfma_f32_32x32x16_bf16(a0, AT_VFR(0), o[0], 0, 0, 0);
  o[1] = __builtin_amdgcn_mfma_f32_32x32x16_bf16(a0, AT_VFR(4), o[1], 0, 0, 0);
  o[0] = __builtin_amdgcn_mfma_f32_32x32x16_bf16(a1, AT_VFR(1), o[0], 0, 0, 0);
  o[1] = __builtin_amdgcn_mfma_f32_32x32x16_bf16(a1, AT_VFR(5), o[1], 0, 0, 0);
  o[0] = __builtin_amdgcn_mfma_f32_32x32x16_bf16(a2, AT_VFR(2), o[0], 0, 0, 0);
  o[1] = __builtin_amdgcn_mfma_f32_32x32x16_bf16(a2, AT_VFR(6), o[1], 0, 0, 0);
  o[0] = __builtin_amdgcn_mfma_f32_32x32x16_bf16(a3, AT_VFR(3), o[0], 0, 0, 0);
  o[1] = __builtin_amdgcn_mfma_f32_32x32x16_bf16(a3, AT_VFR(7), o[1], 0, 0, 0);
#undef AT_VFR
}

__device__ __forceinline__ void row_factors(const Ctx& c, float f, float (&fr)[16]) {
  if (c.hi == 0) c.wsf[c.r32] = f;
  asm volatile("s_waitcnt lgkmcnt(0)" ::: "memory");
#pragma unroll
  for (int r = 0; r < 16; ++r) fr[r] = c.wsf[crow(r, c.hi)];
  asm volatile("s_waitcnt lgkmcnt(0)" ::: "memory");
}
__device__ __forceinline__ void load_z(const Ctx& c, const bf16_t* zbase, u32x4* zv) {
#pragma unroll
  for (int i = 0; i < 4; ++i) zv[i] = *(const u32x4*)(zbase + (size_t)(i * 8 + (c.lane >> 3)) * UP + (c.lane & 7) * 8);
}
__device__ __forceinline__ float silu_mul(float v, unsigned zbits) { const float z = __uint_as_float(zbits); return v * z * __builtin_amdgcn_rcpf(1.f + __builtin_amdgcn_exp2f(-z * LOG2E)); }
__device__ __forceinline__ void epilogue(const Ctx& c, const f32x16* vals, const u32x4* zv, bf16_t* yptr) {
  float* stg = (float*)(c.shm + LDS_OST + c.wid * 8192);
#pragma unroll
  for (int r = 0; r < 16; ++r) { const int row = crow(r, c.hi); stg[row * 64 + c.r32] = vals[0][r]; stg[row * 64 + 32 + c.r32] = vals[1][r]; }
  asm volatile("s_waitcnt lgkmcnt(0)" ::: "memory");
  typedef float f32x4_t __attribute__((ext_vector_type(4)));
#pragma unroll
  for (int i = 0; i < 4; ++i) { const int row = i * 8 + (c.lane >> 3), ch = c.lane & 7;
    const f32x4_t a = *(const f32x4_t*)(stg + row * 64 + ch * 8), b = *(const f32x4_t*)(stg + row * 64 + ch * 8 + 4); const u32x4 z = zv[i];
    u32x4 w; w.x = cvtpk(silu_mul(a.x, z.x << 16), silu_mul(a.y, z.x & 0xffff0000u)); w.y = cvtpk(silu_mul(a.z, z.y << 16), silu_mul(a.w, z.y & 0xffff0000u));
    w.z = cvtpk(silu_mul(b.x, z.z << 16), silu_mul(b.y, z.z & 0xffff0000u)); w.w = cvtpk(silu_mul(b.z, z.w << 16), silu_mul(b.w, z.w & 0xffff0000u));
    *(u32x4*)(yptr + (size_t)row * YP + ch * 8) = w; }
  asm volatile("s_waitcnt lgkmcnt(0)" ::: "memory");
}
__device__ __forceinline__ void load_q(const Ctx& c, const bf16_t* qrow  , bf16x8* q) {
#pragma unroll
  for (int d0 = 0; d0 < 4; ++d0) q[d0] = *(const bf16x8*)(qrow + d0 * 16 + c.hi * 8);
}

__device__ __forceinline__ void moba_unit(const Ctx& c, int b, int h, int qb, bf16x8 (&qr)[4], Ring& rg, UnitP& un, const bf16_t* qnp, const bf16_t* U, const bf16_t* KMHL, const bf16_t* KC, bf16_t* Y) {
  const size_t rowbase = (size_t)b * SEQ; const int row0 = 256 * qb + 32 * c.wid;
  const float slope2 = __builtin_amdgcn_exp2f(-(float)(h + 1)) * LOG2E;
  UnitP u; make_unit(u, 0, b, h, qb, U, KMHL, KC);
  bf16x8 kf[8];
  u32x4 zv[4]; load_z(c, ucol(U, C_ZM + h * 64) + (rowbase + row0) * UP, zv);
  f32x16 o[2]; float m = 0.f, l = 0.f;
  prologue_wait(c, kf, rg);
  unsigned rowmask = 0u;
  {
    const int cnt = step_top(c, u, 0, rg);
    f32x16 pg = f32x16{};
#pragma unroll
    for (int d0 = 0; d0 < 4; ++d0) pg = __builtin_amdgcn_mfma_f32_32x32x16_bf16(kf[2 * d0], qr[d0], pg, 0, 0, 0);
    float own[4], oth[4], sc[8];
#pragma unroll
    for (int i = 0; i < 4; ++i) { own[i] = pg[i] + pg[4 + i]; auto rr = __builtin_amdgcn_permlane32_swap(__float_as_uint(own[i]), __float_as_uint(own[i]), false, false); oth[i] = __uint_as_float(c.hi ? rr[0] : rr[1]); }
#pragma unroll
    for (int i = 0; i < 4; ++i) { sc[i] = c.hi ? oth[i] : own[i]; sc[4 + i] = c.hi ? own[i] : oth[i]; }
#pragma unroll
    for (int n = 0; n < 8; ++n) { int rank = 0;
#pragma unroll
      for (int n2 = 0; n2 < 8; ++n2) if (n2 != n) rank += (int)((n2 < qb) & ((sc[n2] > sc[n]) | ((sc[n2] == sc[n]) & (n2 < n))));
      rowmask |= (unsigned)((n < qb) & (rank < 3)) << n; }
    step_end(c, u, 0, cnt, kf, rg);
  }
  o[0] = f32x16{}; o[1] = f32x16{}; m = 0.f; l = 0.f;
  const float sh = slope2 * (float)(4 * c.hi);
  for (int s = 1; s < u.n; ++s) {
    const int cnt = step_top(c, u, s, rg);
    const int i = s - 1, tile = i < 4 ? 4 * qb + i : i - 4;
    int mode = 0, qx = 0; float rn = 0.f; bool skip = false;
    if (i < 4) { const int lo = 32 * c.wid - 64 * i;
      skip = (lo + 31 < 0); mode = (lo >= 63) ? 0 : 1; qx = lo + c.r32 - 4 * c.hi; }
    else rn = ((rowmask >> (tile >> 2)) & 1u) ? 0.f : NEGINF;
    if (!skip) { f32x16 p0, p1; att_tile<1>(c, rg.vs, kf, next_k(u, s, rg), qr, slope2, slope2 * (float)(64 * tile - 256 * qb) + sh + rn, mode, qx, m, l, o, p0, p1); }
    step_end(c, u, s, cnt, kf, rg, skip);
  }
  prologue_issue(c, un, rg); load_q(c, qnp, qr);
  float fr[16]; row_factors(c, __builtin_amdgcn_rcpf(sum_halves(l)), fr);
#pragma unroll
  for (int r = 0; r < 16; ++r) { o[0][r] *= fr[r]; o[1][r] *= fr[r]; }
  epilogue(c, o, zv, Y + (rowbase + row0) * YP + h * 64);
}

__device__ __forceinline__ float imp_val(const float* IMP, int row, int jj, int qt) {
  float v = ((IMP[(0 * 64 + row) * 33 + jj] + IMP[(1 * 64 + row) * 33 + jj]) + IMP[(2 * 64 + row) * 33 + jj]) + IMP[(3 * 64 + row) * 33 + jj];
  if (jj == 0 || jj == qt || jj == qt - 1) v = 1e4f;
  if (jj > qt) v = -1e9f;
  return v;
}
__device__ __forceinline__ void nsa_unit(const Ctx& c, int b, int g, int qt, bf16x8 (&qr)[4], Ring& rg, UnitP& un, const bf16_t* qnp, const bf16_t* U, const bf16_t* KMHL, const bf16_t* KC, bf16_t* Y) {
  const int j = c.wid >> 1, hf = c.wid & 1, hn = g * 4 + j;
  const size_t rowbase = (size_t)b * SEQ; const int row0 = 64 * qt + 32 * hf;
  const float slope2 = __builtin_amdgcn_exp2f(-(float)(hn + 1)) * LOG2E;
  const bf16_t* glp = ucol(U, C_GL + hn * 3) + (rowbase + row0 + c.r32) * UP;
  float glv0 = bf2f(glp[0]), glv1 = bf2f(glp[1]), glv2 = bf2f(glp[2]);
#define NSA_GATE(k) __builtin_amdgcn_rcpf(1.f + __builtin_amdgcn_exp2f(-((k) == 0 ? glv0 : ((k) == 1 ? glv1 : glv2)) * LOG2E))
  const int qd = 32 * hf + c.r32;
  const int nts = qt + 1, ntw = (qt < 8 ? qt : 8) + 1;
  const bool alls = (qt < 16);
  UnitP u; make_unit(u, 1, b, g, qt, U, KMHL, KC);
  float* IMP = (float*)(c.shm + LDS_IMP);
  unsigned* RM = (unsigned*)(c.shm + LDS_RM);
  float* park = (float*)(c.shm + LDS_OST + c.wid * 8192) + c.lane;
  bf16x8 kf[8];
  prologue_wait(c, kf, rg);
  f32x16 o[2]; o[0] = f32x16{}; o[1] = f32x16{}; float m = 0.f, l = 0.f;
  float G[16], L[16], mA = 0.f;
#pragma unroll
  for (int t = 0; t < 2; ++t) {
    if (t >= u.ncmp) {
#pragma unroll
      for (int i = 0; i < 8; ++i) { G[8 * t + i] = 0.f; L[8 * t + i] = 0.f; }
      continue; }
    const int cnt = step_top(c, u, t, rg);
    f32x16 p0, p1;
    att_tile<16>(c, rg.vs, kf, next_k(u, t, rg), qr, slope2 * 16.f, slope2 * (float)(16 * (64 * t + 4 * c.hi) + 31 - 64 * qt), 1, qd - 16 * (64 * t + 4 * c.hi) - 31 + 64 * qt, m, l, o, p0, p1);
    if (t == 0) mA = m;
#pragma unroll
    for (int cc = 0; cc < 4; ++cc) {
      G[8 * t + cc] = (p0[4 * cc] + p0[4 * cc + 1]) + (p0[4 * cc + 2] + p0[4 * cc + 3]); L[8 * t + cc] = p0[4 * cc + 3];
      G[8 * t + 4 + cc] = (p1[4 * cc] + p1[4 * cc + 1]) + (p1[4 * cc + 2] + p1[4 * cc + 3]); L[8 * t + 4 + cc] = p1[4 * cc + 3]; }
    step_end(c, u, t, cnt, kf, rg, false);
  }
  {
    const float lt = sum_halves(l); const float inv = lt > 0.f ? 1.f / lt : 0.f;
    const float sA = __builtin_amdgcn_exp2f(mA - m) * inv;
    if (!alls) {
    float RL[16];
#pragma unroll
    for (int i = 0; i < 16; ++i) { const float sc = (i < 8) ? sA : inv; G[i] *= sc; L[i] *= sc;
      auto rr = __builtin_amdgcn_permlane32_swap(__float_as_uint(L[i]), __float_as_uint(L[i]), false, false); RL[i] = __uint_as_float(c.hi ? rr[0] : rr[1]); }
#pragma unroll
    for (int i = 0; i < 16; ++i) { const float prev = c.hi ? RL[i] : (i > 0 ? RL[i > 0 ? i - 1 : 0] : 0.f);
      const int jb = 8 * (i >> 2) + 2 * (i & 3) + c.hi;
      IMP[(j * 64 + qd) * 33 + jb] = G[i] + prev; }
    }
    float fr[16]; row_factors(c, NSA_GATE(0) * inv, fr);
#pragma unroll
    for (int r = 0; r < 16; ++r) { o[0][r] *= fr[r]; o[1][r] *= fr[r]; }
  }
  if (!alls) {
  asm volatile("s_waitcnt lgkmcnt(0)\n\ts_barrier" ::: "memory");
  {
    const int tid = c.wid * 64 + c.lane, row = tid >> 3, sub = tid & 7;
    float* S = (float*)(c.shm + LDS_OST);
    float vc[4]; int rank[4];
#pragma unroll
    for (int k = 0; k < 4; ++k) { vc[k] = imp_val(IMP, row, sub * 4 + k, qt); rank[k] = 0; S[row * 33 + sub * 4 + k] = vc[k]; }
    asm volatile("s_waitcnt lgkmcnt(0)\n\ts_barrier" ::: "memory");
    const float* Sr = S + row * 33;
#pragma unroll 8
    for (int jj = 0; jj <= qt; ++jj) { const float v = Sr[jj];
#pragma unroll
      for (int k = 0; k < 4; ++k) rank[k] += (int)((v > vc[k]) | ((v == vc[k]) & (jj < sub * 4 + k))); }
    unsigned bits = 0u;
#pragma unroll
    for (int k = 0; k < 4; ++k) { const int jc = sub * 4 + k; if (rank[k] < 16 && jc <= qt) bits |= (1u << jc); }
    bits |= (unsigned)__builtin_amdgcn_update_dpp(0, (int)bits, 0xB1, 0xF, 0xF, true);
    bits |= (unsigned)__builtin_amdgcn_update_dpp(0, (int)bits, 0x4E, 0xF, 0xF, true);
    bits |= (unsigned)__builtin_amdgcn_update_dpp(0, (int)bits, 0x141, 0xF, 0xF, true);
    if (sub == 0) RM[row] = bits;
  }
  asm volatile("s_waitcnt lgkmcnt(0)\n\ts_barrier" ::: "memory");
  }
  const unsigned rowmask = alls ? ((2u << qt) - 1u) : RM[qd];
  unsigned rem = 0u;
  if (alls) { if (qt >= 5) rem = ((1u << (qt - 3)) - 1u) & ~1u; }
  else if (qt >= 5) {
    unsigned um = RM[c.lane];
    um |= (unsigned)__builtin_amdgcn_update_dpp(0, (int)um, 0xB1, 0xF, 0xF, true); um |= (unsigned)__builtin_amdgcn_update_dpp(0, (int)um, 0x4E, 0xF, 0xF, true);
    um |= (unsigned)__builtin_amdgcn_update_dpp(0, (int)um, 0x141, 0xF, 0xF, true); um |= (unsigned)__builtin_amdgcn_update_dpp(0, (int)um, 0x140, 0xF, 0xF, true);
    { auto rr = __builtin_amdgcn_permlane16_swap(um, um, false, false); um = rr[0] | rr[1]; }
    { auto rr = __builtin_amdgcn_permlane32_swap(um, um, false, false); um = rr[0] | rr[1]; }
    rem = (unsigned)__builtin_amdgcn_readfirstlane((int)um) & (((1u << (qt - 3)) - 1u) & ~1u);
    u.remk = rem; u.remv = rem; u.remc = rem; u.nts = u.npre + __builtin_popcount(rem); u.n = u.ncmp + u.nts + ntw;
  }
  u32x4 zv[4]; load_z(c, ucol(U, C_ZN + hn * 64) + (rowbase + row0) * UP, zv);
#pragma unroll
  for (int r = 0; r < 16; ++r) { park[(2 * r) * 64] = o[0][r]; park[(2 * r + 1) * 64] = o[1][r]; }
  int* TAB = (int*)(c.shm + LDS_TAB);
  if (c.wid == 0) {
    const int ksoff = (int)((const char*)u.k1 - (const char*)U), kwoff = (int)((const char*)u.k2 - (const char*)U);
    const int t = c.lane; int e = -1, tile = 0, kind = 0;
    if (t < 32) { if ((rem >> t) & 1u) { e = u.ncmp + u.npre + __builtin_popcount(rem & ((1u << t) - 1u)); tile = t; } }
    else if (t < 40) { const int jp = t - 32; if (jp < u.npre) { e = u.ncmp + jp; tile = (int)((u.pre >> (5 * jp)) & 31u); } }
    else if (t < 49) { const int jw = t - 40; if (jw < ntw) { e = u.ncmp + u.nts + jw; tile = qt - jw; kind = 1; } }
    if (e >= 0) {
      const int js = e - u.ncmp;
      const int ko = (kind ? kwoff : ksoff) + tile * 8192;
      const int mode = kind ? ((tile == qt) ? 1 : ((qt - tile == 8) ? 2 : 0)) : ((js == 0) ? 1 : 0);
      const int maskf = (!kind && js != 0) ? 1 : 0, fold = (js == u.nts - 1 || e == u.n - 1) ? 1 : 0;
      TAB[e * 4] = ko; TAB[e * 4 + 1] = ko + (int)(DV_N * 2); TAB[e * 4 + 2] = tile | (kind << 5) | (maskf << 6) | (mode << 7) | (fold << 9);
    }
  }
  asm volatile("s_waitcnt lgkmcnt(0)\n\ts_barrier" ::: "memory");
  o[0] = f32x16{}; o[1] = f32x16{}; m = 0.f; l = 0.f;
  const float sh = slope2 * (float)(4 * c.hi); const int qx = qd - 4 * c.hi;
  int nko = TAB[(u.ncmp + KA) * 4], nvo = TAB[(u.ncmp + VA) * 4 + 1], ninfo = TAB[u.ncmp * 4 + 2];
  for (int s = u.ncmp; s < u.n; ++s) {
    int cnt = 0;
    const int ko = nko, vo = nvo; const int info = __builtin_amdgcn_readfirstlane(ninfo);
    nko = TAB[(s + 1 + KA) * 4]; nvo = TAB[(s + 1 + VA) * 4 + 1]; ninfo = TAB[(s + 1) * 4 + 2];
    { const int ek = s + KA, ev = s + VA;
      if (ek < u.n) { dma_k_off(c, U, ko, rg.ks == 0 ? NKS - 1 : rg.ks - 1); ++cnt; }
      if (ev < u.n) { dma_v_off(c, U, vo, rg.vs == 0 ? NVS - 1 : rg.vs - 1); ++cnt; } }
    const int tile = info & 31, mode = (info >> 7) & 3; const bool win = (info >> 5) & 1, fold = (info >> 9) & 1;
    float t0 = slope2 * (float)(64 * (tile - qt)) + sh;
    if ((info >> 6) & 1) t0 += ((rowmask >> tile) & 1u) ? 0.f : NEGINF;
    f32x16 p0, p1; att_tile<1>(c, rg.vs, kf, next_k(u, s, rg), qr, slope2, t0, mode, qx, m, l, o, p0, p1);
    if (fold) {
      float fr[16]; row_factors(c, (win ? NSA_GATE(2) : NSA_GATE(1)) * __builtin_amdgcn_rcpf(sum_halves(l)), fr);
#pragma unroll
      for (int r = 0; r < 16; ++r) { park[(2 * r) * 64] += o[0][r] * fr[r]; park[(2 * r + 1) * 64] += o[1][r] * fr[r]; }
      o[0] = f32x16{}; o[1] = f32x16{}; m = 0.f; l = 0.f;
    }
    step_end(c, u, s, cnt, kf, rg, false);
  }
  prologue_issue(c, un, rg); load_q(c, qnp, qr);
#pragma unroll
  for (int r = 0; r < 16; ++r) { o[0][r] = park[(2 * r) * 64]; o[1][r] = park[(2 * r + 1) * 64]; }
  asm volatile("s_waitcnt lgkmcnt(0)" ::: "memory");
  epilogue(c, o, zv, Y + (rowbase + row0) * YP + 512 + hn * 64);
#undef NSA_GATE
}

__device__ __forceinline__ void unit_of(int v, int uidx, int& type, int& b, int& hg, int& qi) {
  const int r = uidx >> 1, j = v & 7, qb = (j + r) & 7;
  b = v >> 3;
  if ((uidx & 1) == 0) { type = 0; hg = r; qi = qb; }
  else { type = 1; hg = r & 1; qi = 28 - 4 * qb + (r >> 1); }
}
__device__ __forceinline__ void attn_phase(char* shm, const bf16_t* U, const bf16_t* KMHL, const bf16_t* KC, bf16_t* Y, int vcu, const int wid) {
  const int G = gridDim.x;
  for (int vb = blockIdx.x; vb < 256; vb += G) {
    const int v = (vcu >= 0) ? vcu : vb;
    bf16x8 qr[4]; Ring rg;
    for (int uidx = 0; uidx < 16; ++uidx) {
      int lane; asm volatile("v_mbcnt_lo_u32_b32 %0, -1, 0\n\tv_mbcnt_hi_u32_b32 %0, -1, %0" : "=v"(lane));
      Ctx c; c.shm = shm; c.lds0 = (unsigned)(uintptr_t)shm; c.lane = lane; c.r32 = lane & 31; c.hi = lane >> 5; c.wid = wid;
#pragma unroll
      for (int d0 = 0; d0 < 4; ++d0) c.ka.a[d0] = (lds_cptr)shm + LDS_K + c.r32 * 128 + (((2 * d0 + c.hi) ^ ((c.r32 >> 1) & 7)) << 4);
      c.vb0 = 0;
      { const int krow = 8 * wid + (lane >> 3), jp = lane & 7;
        c.koff = (krow * UP + (((lane & 7) ^ ((krow >> 1) & 7)) << 3)) * 2;
        c.voff = (krow * UP + ((((jp >> 1) ^ (((krow >> 1) & 1) << 1)) << 1) | (jp & 1)) * 8) * 2; }
      c.wsf = (float*)(shm + LDS_WS) + wid * 64;
      int type, b, hg, qi; unit_of(v, uidx, type, b, hg, qi);
      if (uidx == 0) { UnitP u0; make_unit(u0, type, b, hg, qi, U, KMHL, KC); prologue_issue(c, u0, rg); load_q(c, q_row(c, type, b, hg, qi, U), qr); }
      int tn, bn, hgn, qin; unit_of(v, uidx < 15 ? uidx + 1 : 15, tn, bn, hgn, qin);
      UnitP un; make_unit(un, tn, bn, hgn, qin, U, KMHL, KC);
      const bf16_t* qnp = q_row(c, tn, bn, hgn, qin, U);
      if (type == 1) nsa_unit(c, b, hg, qi, qr, rg, un, qnp, U, KMHL, KC, Y);
      else moba_unit(c, b, hg, qi, qr, rg, un, qnp, U, KMHL, KC, Y);
    }
    asm volatile("s_waitcnt vmcnt(0)\n\ts_barrier" ::: "memory");
  }
}
#undef AT_WAIT_BAR
#undef AT_SBAR
}
constexpr int NWAVES = 8;
constexpr int BATCH = 32, SEQ = 2048, D = 1024, DEPTH = 2, MROWS = BATCH * SEQ;
constexpr int D_IN = 3864, NU = 4096;
constexpr int N_G1 = 3840;
constexpr float RMS_EPS = 1e-6f;
constexpr float QSCALE = 0.125f * 1.4426950408889634f;

typedef unsigned short bf16;
typedef unsigned v4u __attribute__((ext_vector_type(4)));
typedef float f32x4 __attribute__((ext_vector_type(4)));
typedef short bf16x8 __attribute__((ext_vector_type(8)));
#define LAS __attribute__((address_space(3)))

constexpr size_t MiB = 1u << 20;
constexpr size_t WS_CTL = 0, CTL_ZERO_BYTES = 65536;
constexpr int CW_XR = 1024;
constexpr int CW_BAR = 4096;
constexpr int CW_GRP = 8192;
constexpr size_t WS_WIN = 2 * MiB;
constexpr size_t WS_WOUT = 18 * MiB;
constexpr size_t WS_WC1 = 22 * MiB;
constexpr size_t WS_WC2 = 23 * MiB;
constexpr size_t WS_PEC = 23 * MiB + 512 * 1024;
constexpr size_t WS_MOD = 24 * MiB;
constexpr size_t WS_KMHL = 25 * MiB;
constexpr size_t WS_KC = 26 * MiB, WS_VC = 27 * MiB;
constexpr size_t WS_KMACC = 28 * MiB;
constexpr size_t WS_H = 32 * MiB;
constexpr size_t WS_Y = 160 * MiB;
constexpr size_t WS_O = 288 * MiB;
constexpr size_t WS_U = 416 * MiB;
constexpr size_t WS_END = 928 * MiB;
constexpr int CW_WQ = 64;

constexpr int LDS_BYTES = 163840;
constexpr int LDS_MISC = LDS_BYTES - 256;
static_assert(att::LDS_END <= LDS_MISC, "attention LDS map");

__device__ __forceinline__ unsigned pk2(float lo, float hi) { typedef float f2_t_ __attribute__((ext_vector_type(2))); typedef __bf16 b2_t_ __attribute__((ext_vector_type(2)));
    const f2_t_ v = {lo, hi}; return __builtin_bit_cast(unsigned, __builtin_convertvector(v, b2_t_)); }
__device__ __forceinline__ unsigned f2bf(float f) { return pk2(f, 0.f) & 0xffffu; }
__device__ __forceinline__ float bf2f(unsigned short v) { return __uint_as_float((unsigned)v << 16); }
__device__ __forceinline__ float wave_sum(float v) {
    v += __builtin_bit_cast(float, __builtin_amdgcn_update_dpp(0, __builtin_bit_cast(int, v), 0xB1, 0xF, 0xF, true));
    v += __builtin_bit_cast(float, __builtin_amdgcn_update_dpp(0, __builtin_bit_cast(int, v), 0x4E, 0xF, 0xF, true));
    v += __builtin_bit_cast(float, __builtin_amdgcn_update_dpp(0, __builtin_bit_cast(int, v), 0x141, 0xF, 0xF, true));
    v += __builtin_bit_cast(float, __builtin_amdgcn_update_dpp(0, __builtin_bit_cast(int, v), 0x140, 0xF, 0xF, true));
    { auto rr = __builtin_amdgcn_permlane16_swap(__float_as_uint(v), __float_as_uint(v), false, false); v = __uint_as_float(rr[0]) + __uint_as_float(rr[1]); }
    { auto rr = __builtin_amdgcn_permlane32_swap(__float_as_uint(v), __float_as_uint(v), false, false); v = __uint_as_float(rr[0]) + __uint_as_float(rr[1]); }
    return v;
}

#define GAS __attribute__((address_space(1)))
typedef GAS unsigned gu32;
#define RLX_AGENT __ATOMIC_RELAXED, __HIP_MEMORY_SCOPE_AGENT
#define XB_TMO      128
#define XB_XCNT(j)  (256  + 64 * (j))
#define XB_XSUB(j)  (1280 + 64 * (j))
#define XB_XGEN(j)  (2304 + 64 * (j))
#define XB_TOP      3328
#define XB_TOPGEN   3392
#define XCD_BAR_WORDS 3456
#define XB_SPIN_CAP (1u << 18)

__device__ __forceinline__ unsigned xb_ld(unsigned* p)              { return __hip_atomic_load(p, __ATOMIC_RELAXED, __HIP_MEMORY_SCOPE_AGENT); }
__device__ __forceinline__ unsigned xb_add(unsigned* p, unsigned v) { return __hip_atomic_fetch_add(p, v, __ATOMIC_RELAXED, __HIP_MEMORY_SCOPE_AGENT); }
__device__ __forceinline__ unsigned xb_xcc_id() { return (unsigned)__builtin_amdgcn_s_getreg((3 << 11) | 20) & 0xFu; }
#define XB_SPIN(cond, bar) do { unsigned _sp = 0; while (cond) { __builtin_amdgcn_s_sleep(1); \
    if ((++_sp & 255u) == 0u) { if (xb_ld(&(bar)[XB_TMO])) break; if (_sp > XB_SPIN_CAP) { atomicAdd(&(bar)[XB_TMO], 1u); break; } } } } while (0)

struct XcdBarrier {
    unsigned* bar; unsigned x;
    volatile LAS unsigned* st;
};

__device__ __forceinline__ XcdBarrier xcd_barrier_post(unsigned* bar, volatile LAS unsigned* st) {
    XcdBarrier b; b.bar = bar; b.x = xb_xcc_id(); b.st = st;
    if (threadIdx.x == 0) (void)xb_add(&bar[XB_XCNT(b.x)], 1u);
    return b;
}
__device__ __forceinline__ void xcd_barrier_complete(unsigned* bar, unsigned x, unsigned& nloc, unsigned& nx) {
    const unsigned G = gridDim.x * gridDim.y * gridDim.z;
    unsigned sum, cnt, mine, sp = 0u;
    for (;;) {
        sum = 0u; cnt = 0u; mine = 0u;
#pragma unroll
        for (unsigned j = 0; j < 16; ++j) { const unsigned c = xb_ld(&bar[XB_XCNT(j)]); sum += c; cnt += (c > 0u) ? 1u : 0u; mine = (j == x) ? c : mine; }
        if (sum == G) break;
        __builtin_amdgcn_s_sleep(1);
        if ((++sp & 255u) == 0u) { if (xb_ld(&bar[XB_TMO])) break; if (sp > XB_SPIN_CAP) { atomicAdd(&bar[XB_TMO], 1u); break; } }
    }
    nloc = mine > 0u ? mine : 1u; nx = cnt > 0u ? cnt : 1u;
}

__device__ __forceinline__ void xcd_barrier(const XcdBarrier& b, const bool t0  ) {
    asm volatile("s_waitcnt vmcnt(0)" ::: "memory");
    __syncthreads();
    if (t0) {
        unsigned* bar = b.bar;
        __builtin_amdgcn_s_waitcnt(0);
        unsigned nloc = b.st[0], nx = b.st[1];
        if (nloc == 0u) { xcd_barrier_complete(bar, b.x, nloc, nx); b.st[0] = nloc; b.st[1] = nx; }
        const unsigned old = xb_add(&bar[XB_XSUB(b.x)], 1u);
        const unsigned gen = old / nloc;
        if (old + 1u == (gen + 1u) * nloc) {
            __builtin_amdgcn_fence(__ATOMIC_RELEASE, "agent");
            asm volatile("s_waitcnt vmcnt(0)" ::: "memory");
            const unsigned og = xb_add(&bar[XB_TOP], 1u);
            const unsigned tg = og / nx;
            if (og + 1u == (tg + 1u) * nx) xb_add(&bar[XB_TOPGEN], 1u);
            else XB_SPIN(xb_ld(&bar[XB_TOPGEN]) == tg, bar);
            __builtin_amdgcn_fence(__ATOMIC_ACQUIRE, "agent");
            xb_add(&bar[XB_XGEN(b.x)], 1u);
            asm volatile("s_waitcnt vmcnt(0)" ::: "memory");
        } else {
            XB_SPIN(xb_ld(&bar[XB_XGEN(b.x)]) == gen, bar);
            __builtin_amdgcn_fence(__ATOMIC_ACQUIRE, "agent");
            asm volatile("s_waitcnt vmcnt(0)" ::: "memory");
        }
    }
    __syncthreads();
}

__device__ __forceinline__ void group_barrier(unsigned* bar, unsigned* cnt, unsigned target, bool same_xcd, const bool t0) {
    asm volatile("s_waitcnt vmcnt(0)" ::: "memory");
    __syncthreads();
    if (t0) {
        __builtin_amdgcn_s_waitcnt(0);
        if (!same_xcd) { __builtin_amdgcn_fence(__ATOMIC_RELEASE, "agent"); asm volatile("s_waitcnt vmcnt(0)" ::: "memory"); }
        (void)xb_add(cnt, 1u);
        XB_SPIN(xb_ld(cnt) < target, bar);
        __builtin_amdgcn_fence(__ATOMIC_ACQUIRE, "agent");
        asm volatile("s_waitcnt vmcnt(0)" ::: "memory");
    }
    __syncthreads();
}

__device__ __forceinline__ int lane_id() { int l; asm volatile("v_mbcnt_lo_u32_b32 %0, -1, 0\n\tv_mbcnt_hi_u32_b32 %0, -1, %0" : "=v"(l)); return l; }

struct Args { const float* in[14]; float* out; unsigned char* ws; int cg_seam; int pad_; };

__device__ __forceinline__ void tr_load(const float* W, int N, int item, int lane, float (&tv)[32]) {
    const int nblk = (N + 31) / 32, kb = item / nblk, nb = item % nblk, k0 = 64 * kb, n0 = 32 * nb;
    const int nl = n0 + (lane & 31);
#pragma unroll
    for (int i = 0; i < 32; ++i) { const int kk = 2 * i + (lane >> 5); tv[i] = (nl < N) ? W[(size_t)(k0 + kk) * N + nl] : 0.f; }
}
__device__ __forceinline__ void tr_store(const int MAP, int K, int N, bf16* WT, LAS float* scr, int item, int lane, const float (&tv)[32]) {
    const int nblk = (N + 31) / 32, kb = item / nblk, nb = item % nblk, k0 = 64 * kb, n0 = 32 * nb;
#pragma unroll
    for (int i = 0; i < 32; ++i) { const int kk = 2 * i + (lane >> 5); scr[kk * 33 + (lane & 31)] = tv[i]; }
    asm volatile("s_waitcnt lgkmcnt(0)" ::: "memory");
    const int c = lane & 7;
#pragma unroll
    for (int j = 0; j < 4; ++j) { const int n = (lane >> 3) + 8 * j; const int ns = n0 + n; const LAS float* s = scr + (8 * c) * 33 + n;
        int nd = ns; float sc = 1.f;
        if (MAP == 1) { if (ns >= 3328 && ns < 3352) nd = ns + 512; else if (ns >= 3352) nd = ns - 24; if (ns < 512 || (ns >= 2048 && ns < 2560)) sc = QSCALE; }
        v4u o; o.x = pk2(s[0 * 33] * sc, s[1 * 33] * sc); o.y = pk2(s[2 * 33] * sc, s[3 * 33] * sc); o.z = pk2(s[4 * 33] * sc, s[5 * 33] * sc); o.w = pk2(s[6 * 33] * sc, s[7 * 33] * sc);
        if (ns < N) *(v4u*)(WT + (size_t)nd * K + k0 + 8 * c) = o; }
    asm volatile("s_waitcnt lgkmcnt(0)" ::: "memory");
}

__device__ __forceinline__ void weight_copies(const Args& a, LAS float* scr, int first, int stride, int lane) {
    unsigned char* ws = a.ws;
    constexpr int I_IN = (D / 64) * ((D_IN + 31) / 32);
    constexpr int I_OUT = (D / 64) * (D / 32);
    constexpr int I_C1 = (2048 / 64) * (64 / 32);
    constexpr int I_C2 = 1 * 2;
    constexpr int I_PAD = 232;
    constexpr int PER_L = I_IN + I_OUT + 2 * I_C1 + 2 * I_C2 + I_PAD;
    for (int it = first; it < PER_L; it += stride) {
        int r = it;
        bf16* win_t = (bf16*)(ws + WS_WIN);
        const float* W; bf16* WT; int K, N, map = 0, item; size_t ws1, wt1;
        if (r < I_IN) { W = a.in[6]; ws1 = (size_t)D * D_IN; K = D; N = D_IN; WT = win_t; wt1 = (size_t)NU * D; map = 1; item = r; }
        else if ((r -= I_IN) < I_OUT) { W = a.in[7]; ws1 = (size_t)D * D; K = D; N = D; WT = (bf16*)(ws + WS_WOUT); wt1 = (size_t)D * D; item = r; }
        else if ((r -= I_OUT) < 2 * I_C1) { const int kv = r >= I_C1; W = a.in[kv ? 12 : 10]; ws1 = (size_t)2048 * 64; K = 2048; N = 64; WT = (bf16*)(ws + WS_WC1) + (size_t)kv * 64 * 2048; wt1 = (size_t)2 * 64 * 2048; item = r - kv * I_C1; }
        else if ((r -= 2 * I_C1) < 2 * I_C2) { const int kv = r >= I_C2; W = a.in[kv ? 13 : 11]; ws1 = (size_t)64 * 64; K = 64; N = 64; WT = (bf16*)(ws + WS_WC2) + (size_t)kv * 64 * 64; wt1 = (size_t)2 * 64 * 64; item = r - kv * I_C2; }
        else { r -= 2 * I_C2; W = nullptr; WT = nullptr; K = 0; N = 0; item = 0; ws1 = 0; wt1 = 0; }
        if (W) { float t0[32], t1[32];
            tr_load(W, N, item, lane, t0); tr_load(W + ws1, N, item, lane, t1);
            tr_store(map, K, N, WT, scr, item, lane, t0); tr_store(map, K, N, WT + wt1, scr + 64 * 33, item, lane, t1);
            continue; }
        { v4u z = {0u, 0u, 0u, 0u};
#pragma unroll
          for (int l = 0; l < 2; ++l) { v4u* p = (v4u*)(win_t + (size_t)l * NU * D + (size_t)(D_IN + r) * D); p[lane] = z; p[lane + 64] = z; } }
    }
}

__device__ __forceinline__ void p0_prologue(const Args& a, LAS unsigned char* lds, int bid, int G, int tid, int wave, int lane) {
    unsigned char* ws = a.ws;
    float wv[8][8];
    auto ada_load = [&](int item) {
        const int l = item / 96, n0 = (item % 96) * 32;
        const int r32 = lane & 31, hi = lane >> 5;
        const float* W = a.in[2] + (size_t)l * D * 3072 + n0 + r32;
        unsigned wp = (unsigned)(wave * 128 + 8 * hi) * 3072u; asm volatile("" : "+v"(wp));
#pragma unroll
        for (int st = 0; st < 8; ++st) {
#pragma unroll
            for (int j = 0; j < 8; ++j) { wv[st][j] = W[wp]; wp += 3072u; asm volatile("" : "+v"(wp)); }
            wp += 8u * 3072u; asm volatile("" : "+v"(wp)); } };
    if (bid < 2 * 96) ada_load(bid);
    { const v4u z = {0u, 0u, 0u, 0u}; for (int i = bid * 512 + tid; i < 65536; i += G * 512) ((v4u*)(ws + WS_KMACC))[i] = z; }
    weight_copies(a, (LAS float*)(lds + wave * 20480), bid * NWAVES + wave, G * NWAVES, lane);
    if (bid >= G - 16) { const int id = bid - (G - 16), lkv = id >> 2, nq = id & 3, l = lkv >> 1, kv = lkv & 1;
        const float* pe = a.in[kv ? 9 : 8] + (size_t)l * 2048; const float* w1 = a.in[kv ? 12 : 10] + (size_t)l * 2048 * 64;
        const int n4 = tid & 3, sl = tid >> 2;
        f32x4 wr[16], pv[4];
#pragma unroll
        for (int i = 0; i < 16; ++i) wr[i] = ((const f32x4*)(w1 + (size_t)(sl * 16 + i) * 64))[nq * 4 + n4];
#pragma unroll
        for (int i = 0; i < 4; ++i) pv[i] = ((const f32x4*)(pe + sl * 16))[i];
        f32x4 s = {0.f, 0.f, 0.f, 0.f};
#pragma unroll
        for (int i = 0; i < 16; ++i) s += wr[i] * pv[i >> 2][i & 3];
        __syncthreads();
        LAS f32x4* red = (LAS f32x4*)lds; red[sl * 4 + n4] = s;
        __syncthreads();
        if (tid < 4) { f32x4 t = {0.f, 0.f, 0.f, 0.f};
#pragma unroll 16
            for (int w = 0; w < 128; ++w) t += red[w * 4 + tid];
            ((f32x4*)(ws + WS_PEC))[(l * 2 + kv) * 16 + nq * 4 + tid] = t; }
    }
    __syncthreads();
    for (int item = bid; item < 2 * 96; item += G) {
        const int l = item / 96, n0 = (item % 96) * 32;
        const int r32 = lane & 31, hi = lane >> 5;
        if (item != bid) ada_load(item);
        const float* cb = a.in[1] + (size_t)r32 * D + wave * 128 + 8 * hi;
        f32x4 ca[8][2];
#pragma unroll
        for (int st = 0; st < 8; ++st) { ca[st][0] = *(const f32x4*)(cb + st * 16); ca[st][1] = *(const f32x4*)(cb + st * 16 + 4); }
        att::f32x16 acc = att::f32x16{};
#pragma unroll
        for (int st = 0; st < 8; ++st) {
            unsigned ah[4], al[4], bh[4], bl[4];
#pragma unroll
            for (int q = 0; q < 4; ++q) {
                float x0 = ca[st][q >> 1][(q & 1) * 2], x1 = ca[st][q >> 1][(q & 1) * 2 + 1];
                x0 = x0 / (1.f + __expf(-x0)); x1 = x1 / (1.f + __expf(-x1));
                const unsigned h0 = f2bf(x0), h1 = f2bf(x1);
                ah[q] = h0 | (h1 << 16); al[q] = pk2(x0 - __uint_as_float(h0 << 16), x1 - __uint_as_float(h1 << 16));
                const float w0 = wv[st][2 * q], w1 = wv[st][2 * q + 1]; const unsigned g0 = f2bf(w0), g1 = f2bf(w1);
                bh[q] = g0 | (g1 << 16); bl[q] = pk2(w0 - __uint_as_float(g0 << 16), w1 - __uint_as_float(g1 << 16)); }
            const v4u ahv = {ah[0], ah[1], ah[2], ah[3]}, alv = {al[0], al[1], al[2], al[3]}, bhv = {bh[0], bh[1], bh[2], bh[3]}, blv = {bl[0], bl[1], bl[2], bl[3]};
            acc = __builtin_amdgcn_mfma_f32_32x32x16_bf16(__builtin_bit_cast(bf16x8, ahv), __builtin_bit_cast(bf16x8, bhv), acc, 0, 0, 0);
            acc = __builtin_amdgcn_mfma_f32_32x32x16_bf16(__builtin_bit_cast(bf16x8, alv), __builtin_bit_cast(bf16x8, bhv), acc, 0, 0, 0);
            acc = __builtin_amdgcn_mfma_f32_32x32x16_bf16(__builtin_bit_cast(bf16x8, ahv), __builtin_bit_cast(bf16x8, blv), acc, 0, 0, 0);
        }
        LAS float* part = (LAS float*)lds + wave * 1024;
#pragma unroll
        for (int r = 0; r < 16; ++r) part[((r & 3) + 8 * (r >> 2) + 4 * hi) * 32 + r32] = acc[r];
        __syncthreads();
        for (int o = tid; o < 1024; o += 512) { const int b = o >> 5, cc = o & 31; float s = 0.f;
#pragma unroll
            for (int w = 0; w < 8; ++w) s += ((LAS float*)lds)[w * 1024 + o];
            ((float*)(ws + WS_MOD))[((size_t)l * 32 + b) * 3072 + n0 + cc] = s + a.in[3][(size_t)l * 3072 + n0 + cc]; }
        __syncthreads();
    }
}

__device__ __forceinline__ void pack_row(const f32x4 (&v)[4], unsigned long long (&w)[4]) {
#pragma unroll
    for (int j = 0; j < 4; ++j) w[j] = (unsigned long long)pk2(v[j].x, v[j].y) | ((unsigned long long)pk2(v[j].z, v[j].w) << 32);
}
__device__ __forceinline__ void store_row_w(bf16* orow, int lane, const unsigned long long (&w)[4]) {
    unsigned long long* o8 = (unsigned long long*)orow + lane;
#pragma unroll
    for (int j = 0; j < 4; ++j) o8[64 * j] = w[j];
}
__device__ __forceinline__ void store_bf16_row(bf16* orow, int lane, const f32x4 (&v)[4]) { unsigned long long w[4]; pack_row(v, w); store_row_w(orow, lane, w); }
constexpr int GL_PITCH = 2064, GL_PART = 2 * 16 * GL_PITCH;
struct GateW { bf16x8 w[2][4]; };
__device__ __forceinline__ void gl_load_w(GateW& g, const bf16* win_t, int wave, int lane) {
    const int fr = lane & 15, fq = lane >> 4;
#pragma unroll
    for (int nt = 0; nt < 2; ++nt)
#pragma unroll
        for (int kk = 0; kk < 4; ++kk) g.w[nt][kk] = *(const bf16x8*)(win_t + (size_t)(N_G1 + 16 * nt + fr) * D + 128 * wave + 32 * kk + 8 * fq);
}
__device__ __forceinline__ void gl_put_row_w(LAS unsigned char* lds, int sb, int slot, int lane, const unsigned long long (&w)[4]) {
    LAS unsigned long long* p = (LAS unsigned long long*)(lds + (sb * 16 + slot) * GL_PITCH) + lane;
#pragma unroll
    for (int j = 0; j < 4; ++j) p[64 * j] = w[j];
}
__device__ __forceinline__ void gl_partial(LAS unsigned char* lds, int sb, int wave, int lane, const GateW& g) {
    const int fr = lane & 15, fq = lane >> 4;
    f32x4 acc[2] = {(f32x4){0.f, 0.f, 0.f, 0.f}, (f32x4){0.f, 0.f, 0.f, 0.f}};
#pragma unroll
    for (int kk = 0; kk < 4; ++kk) { const bf16x8 af = *(const LAS bf16x8*)(lds + (sb * 16 + fr) * GL_PITCH + (128 * wave + 32 * kk + 8 * fq) * 2);
#pragma unroll
        for (int nt = 0; nt < 2; ++nt) acc[nt] = __builtin_amdgcn_mfma_f32_16x16x32_bf16(af, g.w[nt][kk], acc[nt], 0, 0, 0); }
    LAS float* part = (LAS float*)(lds + GL_PART + (sb * 8 + wave) * 2048);
#pragma unroll
    for (int nt = 0; nt < 2; ++nt)
#pragma unroll
        for (int r = 0; r < 4; ++r) part[(4 * fq + r) * 32 + 16 * nt + fr] = acc[nt][r];
}
__device__ __forceinline__ void gl_reduce(LAS unsigned char* lds, int s, int tid, bf16* glt) {
    const int slot = tid >> 5, col = tid & 31; float t = 0.f;
    const LAS float* part = (const LAS float*)(lds + GL_PART + ((s & 1) * 8) * 2048) + slot * 32 + col;
#pragma unroll
    for (int w = 0; w < 8; ++w) t += part[w * 512];
    glt[(size_t)(32 * (slot >> 1) + 2 * s + (slot & 1)) * 64 + col] = (bf16)f2bf(t);
}
__device__ __forceinline__ void prenorm0_phase(const Args& a, LAS unsigned char* lds, int bid, int G, int tid, int wave, int lane) {
    const float* mod = (const float*)(a.ws + WS_MOD); bf16* H = (bf16*)(a.ws + WS_H);
    GateW gwt; gl_load_w(gwt, (const bf16*)(a.ws + WS_WIN), wave, lane);
    for (int blk = bid; blk < MROWS / 256; blk += G) {
        const int m0 = blk * 256 + wave * 32, b = m0 / SEQ;
        bf16* glt = (bf16*)att::ucol((const bf16*)(a.ws + WS_U), att::C_GL) + (size_t)blk * 256 * 64;
        f32x4 gs[4], sh[4];
#pragma unroll
        for (int j = 0; j < 4; ++j) { const int k4 = lane + 64 * j; const f32x4 g = ((const f32x4*)a.in[4])[k4]; const f32x4 sc = ((const f32x4*)(mod + (size_t)b * 3072 + 1024))[k4];
            gs[j] = g * (sc + 1.f); sh[j] = ((const f32x4*)(mod + (size_t)b * 3072))[k4]; }
        f32x4 nx[4];
        { const f32x4* xr = (const f32x4*)(a.in[0] + (size_t)m0 * D) + lane;
#pragma unroll
          for (int j = 0; j < 4; ++j) nx[j] = xr[64 * j]; }
        for (int s = 0; s < 16; ++s) {
#pragma unroll
            for (int e = 0; e < 2; ++e) {
                const int m = m0 + 2 * s + e;
                f32x4 v[4]; float ss = 0.f;
#pragma unroll
                for (int j = 0; j < 4; ++j) v[j] = nx[j];
                if (2 * s + e + 1 < 32) { const f32x4* xr = (const f32x4*)(a.in[0] + (size_t)(m + 1) * D) + lane;
#pragma unroll
                    for (int j = 0; j < 4; ++j) nx[j] = xr[64 * j]; }
#pragma unroll
                for (int j = 0; j < 4; ++j) ss += (v[j].x * v[j].x + v[j].y * v[j].y) + (v[j].z * v[j].z + v[j].w * v[j].w);
                const float rstd = 1.f / sqrtf(wave_sum(ss) * (1.f / D) + RMS_EPS);
#pragma unroll
                for (int j = 0; j < 4; ++j) v[j] = v[j] * rstd * gs[j] + sh[j];
                { unsigned long long w[4]; pack_row(v, w); store_row_w(H + (size_t)m * D, lane, w); gl_put_row_w(lds, s & 1, 2 * wave + e, lane, w); }
            }
            __syncthreads();
            gl_partial(lds, s & 1, wave, lane, gwt);
            if (s > 0) gl_reduce(lds, s - 1, tid, glt);
        }
        __syncthreads();
        gl_reduce(lds, 15, tid, glt);
        __syncthreads();
    }
}
template <int L>
__device__ __forceinline__ void pn_load(const Args& a, const bf16* O, int m, int lane, unsigned long long (&no)[4], f32x4 (&nx)[4], unsigned long long (&nb)[4]) {
    const unsigned long long* orow = (const unsigned long long*)(O + (size_t)m * D) + lane;
#pragma unroll
    for (int j = 0; j < 4; ++j) no[j] = orow[64 * j];
    if constexpr (L == 0) { const f32x4* xr = (const f32x4*)(a.in[0] + (size_t)m * D) + lane;
#pragma unroll
        for (int j = 0; j < 4; ++j) nx[j] = xr[64 * j]; }
    else { const unsigned long long* xb = (const unsigned long long*)((const char*)a.out + (size_t)m * (D * 4)) + lane;
#pragma unroll
        for (int j = 0; j < 4; ++j) nb[j] = xb[64 * j]; }
}
__device__ __forceinline__ f32x4 unpack4(unsigned long long w) { f32x4 r; r.x = bf2f((unsigned short)w); r.y = bf2f((unsigned short)(w >> 16)); r.z = bf2f((unsigned short)(w >> 32)); r.w = bf2f((unsigned short)(w >> 48)); return r; }
template <int L>
__device__ __forceinline__ void postnorm_phase(const Args& a, LAS unsigned char* lds, int bid, int G, int tid, int wave, int lane) {
    const float* mod = (const float*)(a.ws + WS_MOD) + (size_t)L * 32 * 3072; const bf16* O = (const bf16*)(a.ws + WS_O); bf16* H = (bf16*)(a.ws + WS_H);
    GateW gwt;
    if constexpr (L == 0) gl_load_w(gwt, (const bf16*)(a.ws + WS_WIN) + (size_t)NU * D, wave, lane);
    for (int blk = bid; blk < MROWS / 256; blk += G) {
        const int m0 = blk * 256 + wave * 32, b = m0 / SEQ;
        bf16* glt = (bf16*)att::ucol((const bf16*)(a.ws + WS_U), att::C_GL) + (size_t)blk * 256 * 64;
        f32x4 gp[4];
#pragma unroll
        for (int j = 0; j < 4; ++j) { const int k4 = lane + 64 * j; gp[j] = ((const f32x4*)(a.in[5] + (size_t)L * D))[k4] * ((const f32x4*)(mod + (size_t)b * 3072 + 2048))[k4]; }
        f32x4 g1s[4], sh1[4];
        if constexpr (L == 0) { const float* mod1 = (const float*)(a.ws + WS_MOD) + (size_t)32 * 3072 + (size_t)b * 3072;
#pragma unroll
            for (int j = 0; j < 4; ++j) { const int k4 = lane + 64 * j; const f32x4 g = ((const f32x4*)(a.in[4] + D))[k4]; const f32x4 sc = ((const f32x4*)(mod1 + 1024))[k4];
                g1s[j] = g * (sc + 1.f); sh1[j] = ((const f32x4*)mod1)[k4]; } }
        unsigned long long no[4], nb[4]; f32x4 nx[4];
        pn_load<L>(a, O, m0, lane, no, nx, nb);
        for (int s = 0; s < 16; ++s) {
#pragma unroll
            for (int e = 0; e < 2; ++e) {
                const int m = m0 + 2 * s + e;
                f32x4 o[4], x[4]; float ss = 0.f;
#pragma unroll
                for (int j = 0; j < 4; ++j) { o[j] = unpack4(no[j]); if constexpr (L == 0) x[j] = nx[j]; else x[j] = unpack4(nb[j]); }
                if (2 * s + e + 1 < 32) pn_load<L>(a, O, m + 1, lane, no, nx, nb);
#pragma unroll
                for (int j = 0; j < 4; ++j) ss += (o[j].x * o[j].x + o[j].y * o[j].y) + (o[j].z * o[j].z + o[j].w * o[j].w);
                const float rstd = 1.f / sqrtf(wave_sum(ss) * (1.f / D) + RMS_EPS);
                float s2 = 0.f;
#pragma unroll
                for (int j = 0; j < 4; ++j) { x[j] = x[j] + o[j] * rstd * gp[j]; s2 += (x[j].x * x[j].x + x[j].y * x[j].y) + (x[j].z * x[j].z + x[j].w * x[j].w); }
                if constexpr (L == 0) {
                    store_bf16_row((bf16*)((char*)a.out + (size_t)m * (D * 4)), lane, x);
                    const float rstd2 = 1.f / sqrtf(wave_sum(s2) * (1.f / D) + RMS_EPS);
#pragma unroll
                    for (int j = 0; j < 4; ++j) x[j] = x[j] * rstd2 * g1s[j] + sh1[j];
                    { unsigned long long w[4]; pack_row(x, w); store_row_w(H + (size_t)m * D, lane, w); gl_put_row_w(lds, s & 1, 2 * wave + e, lane, w); }
                } else {
                    f32x4* outr = (f32x4*)(a.out + (size_t)m * D) + lane;
#pragma unroll
                    for (int j = 0; j < 4; ++j) outr[64 * j] = x[j];
                }
            }
            if constexpr (L == 0) {
                __syncthreads();
                gl_partial(lds, s & 1, wave, lane, gwt);
                if (s > 0) gl_reduce(lds, s - 1, tid, glt);
            }
        }
        if constexpr (L == 0) {
            __syncthreads();
            gl_reduce(lds, 15, tid, glt);
            __syncthreads();
        }
    }
}

__device__ __forceinline__ float gelu_tanh(float x) {
    const float z = 0.7978845608028654f * (x + 0.044715f * x * x * x);
    const float e = __expf(2.f * z);
    const float t = 1.f - 2.f / (1.f + e);
    return 0.5f * x * (1.f + t);
}
__device__ __forceinline__ void kmean_compress_phase(const Args& a, int l, LAS unsigned char* lds, int bid, int G, int tid, int wave, int lane) {
    const bf16* U = (const bf16*)(a.ws + WS_U);
    const float* KA = (const float*)(a.ws + WS_KMACC) + (size_t)l * 131072;
    auto km_put = [&](int i, float sum) {
        const int cc = i & 63, n = (i >> 6) & 7, bh = i >> 9;
        const float mean = sum * (1.f / 256.f);
        const unsigned hi = f2bf(mean); const float lo = mean - __uint_as_float(hi << 16);
        bf16* KM = (bf16*)(a.ws + WS_KMHL) + (size_t)(bh * 16) * 64;
        KM[n * 64 + cc] = (bf16)hi; KM[(8 + n) * 64 + cc] = (bf16)f2bf(lo); };
    const int km_i0 = bid * 512 + tid;
    float km_v0 = (km_i0 < 131072) ? KA[km_i0] : 0.f;
    bool km_pending = true;
    for (int base = bid * 4; base < 1024; base += G * 4) {
        const int item = base + (wave & 3), hk = wave >> 2;
        const int tt = item & 7, kv = (item >> 3) & 1, g = (item >> 4) & 1, b = item >> 5;
        const int tt0 = base & 7;
        const int fr = lane & 15, fq = lane >> 4;
        f32x4 acc[4];
        {
            const int nblk = (tt0 == 4) ? 128 : 130;
            const char* ublk = (const char*)(att::ucol(U, (kv ? att::C_VC : att::C_KC) + g * 64) + ((size_t)b * SEQ + 256 * tt0) * 64);
            const unsigned lds0 = (unsigned)(uintptr_t)lds;
            for (int j = wave; j < nblk; j += 8)
                att::glds16(ublk + j * 1024 + ((lane ^ ((j >> 1) & 15)) << 4), (unsigned)__builtin_amdgcn_readfirstlane((int)(lds0 + j * 1024)));
            const bf16* W1 = (const bf16*)(a.ws + WS_WC1) + (size_t)(l * 2 + kv) * 64 * 2048 + (size_t)fr * 2048 + 8 * fq + 4 * wave * 64;
            bf16x8 bw[4][8];
#pragma unroll
            for (int nt = 0; nt < 4; ++nt)
#pragma unroll
                for (int ks = 0; ks < 8; ++ks) bw[nt][ks] = *(const bf16x8*)(W1 + (size_t)nt * 16 * 2048 + ks * 32);
            if (km_pending) { km_pending = false; if (km_i0 < 131072) km_put(km_i0, km_v0);
                for (int i = km_i0 + G * 512; i < 131072; i += G * 512) km_put(i, KA[i]); }
            asm volatile("s_waitcnt vmcnt(0)" ::: "memory");
            __syncthreads();
            f32x4 pa[4][4];
#pragma unroll
            for (int mt = 0; mt < 4; ++mt)
#pragma unroll
                for (int nt = 0; nt < 4; ++nt) pa[mt][nt] = (f32x4){0.f, 0.f, 0.f, 0.f};
#pragma unroll
            for (int ks = 0; ks < 8; ++ks) {
                const int li = 4 * wave + (ks >> 1), kk = ks & 1;
#pragma unroll
                for (int mt = 0; mt < 4; ++mt) {
                    int tl = 16 * mt + fr; if (16 * tt0 + tl > 126) tl = 126 - 16 * tt0;
                    const int rel = 16 * tl + li, blk = rel >> 3;
                    const bf16x8 af = *(const LAS bf16x8*)(lds + blk * 1024 + (((((rel & 7) << 3) + kk * 4 + fq) ^ ((blk >> 1) & 15)) << 4));
#pragma unroll
                    for (int nt = 0; nt < 4; ++nt) pa[mt][nt] = __builtin_amdgcn_mfma_f32_16x16x32_bf16(af, bw[nt][ks], pa[mt][nt], 0, 0, 0);
                }
            }
            __syncthreads();
            LAS float* xw = (LAS float*)lds + wave * 4096 + lane;
#pragma unroll
            for (int mt = 0; mt < 4; ++mt)
#pragma unroll
                for (int nt = 0; nt < 4; ++nt)
#pragma unroll
                    for (int r = 0; r < 4; ++r) xw[(mt * 16 + nt * 4 + r) * 64] = pa[mt][nt][r];
        }
        __syncthreads();
        if (hk == 0 && item < 1024) {
            const bf16* W2 = (const bf16*)(a.ws + WS_WC2) + (size_t)(l * 2 + kv) * 64 * 64 + (size_t)fr * 64 + 8 * fq;
            bf16x8 w2v[2][4];
#pragma unroll
            for (int kk = 0; kk < 2; ++kk)
#pragma unroll
                for (int nt = 0; nt < 4; ++nt) w2v[kk][nt] = *(const bf16x8*)(W2 + (size_t)nt * 16 * 64 + kk * 32);
#pragma unroll
            for (int nt = 0; nt < 4; ++nt)
#pragma unroll
                for (int r = 0; r < 4; ++r) { const LAS float* xr = (const LAS float*)lds + (wave * 16 + nt * 4 + r) * 64 + lane; float sm = 0.f;
#pragma unroll
                    for (int w8 = 0; w8 < 8; ++w8) sm += xr[w8 * 4096];
                    acc[nt][r] = sm; }
            LAS bf16* hs = (LAS bf16*)(lds + 131072 + wave * 4096);
            const float* pec = (const float*)(a.ws + WS_PEC) + (l * 2 + kv) * 64;
#pragma unroll
            for (int nt = 0; nt < 4; ++nt) { const float pc = pec[16 * nt + fr];
#pragma unroll
                for (int r = 0; r < 4; ++r) hs[(4 * fq + r) * 72 + 16 * nt + fr] = (bf16)f2bf(gelu_tanh(acc[nt][r] + pc)); }
            asm volatile("s_waitcnt lgkmcnt(0)" ::: "memory");
            f32x4 acc2[4];
#pragma unroll
            for (int nt = 0; nt < 4; ++nt) acc2[nt] = (f32x4){0.f, 0.f, 0.f, 0.f};
#pragma unroll
            for (int kk = 0; kk < 2; ++kk) { const bf16x8 af = *(const LAS bf16x8*)(hs + fr * 72 + kk * 32 + 8 * fq);
#pragma unroll
                for (int nt = 0; nt < 4; ++nt) acc2[nt] = __builtin_amdgcn_mfma_f32_16x16x32_bf16(af, w2v[kk][nt], acc2[nt], 0, 0, 0); }
            bf16* dst = (bf16*)(a.ws + (kv ? WS_VC : WS_KC)) + (size_t)((b * 2 + g) * 128) * 64;
#pragma unroll
            for (int nt = 0; nt < 4; ++nt)
#pragma unroll
                for (int r = 0; r < 4; ++r) { const int trow = tt * 16 + 4 * fq + r; dst[trow * 64 + 16 * nt + fr] = (trow < 127) ? (bf16)f2bf(acc2[nt][r]) : (bf16)0; }
            asm volatile("s_waitcnt lgkmcnt(0)" ::: "memory");
        }
        __syncthreads();
    }
}

#ifndef REP_ATT
#define REP_ATT 1
#endif
#ifndef REP_GEMM
#define REP_GEMM 1
#endif
#ifndef REP_ROW
#define REP_ROW 1
#endif
#ifndef REP_KC
#define REP_KC 1
#endif
__global__ void __launch_bounds__(NWAVES * 64, 2) hybrid_fwd(Args args) {
    extern __shared__ __attribute__((aligned(16))) unsigned char lds[];
    cg::grid_group grid = cg::this_grid();
    LAS unsigned char* L = (LAS unsigned char*)lds;
    const int wave = __builtin_amdgcn_readfirstlane(threadIdx.x >> 6);
    const int G = gridDim.x, bid = blockIdx.x;
    unsigned char* ws = args.ws;
    const int gw = bid * NWAVES + wave;
    volatile LAS unsigned* MISC = (volatile LAS unsigned*)(L + LDS_MISC);
    if (threadIdx.x < 32) MISC[threadIdx.x] = 0u;
    __syncthreads();
    XcdBarrier bar = xcd_barrier_post((unsigned*)(ws + WS_CTL) + CW_BAR, MISC + 8);
    if (threadIdx.x == 0) { const unsigned x = xb_xcc_id(); MISC[16] = x; MISC[17] = atomicAdd((unsigned*)(ws + WS_CTL) + CW_XR + 64 * x, 1u); }
#define GRID_BAR() do { XcdBarrier b_ = bar; asm volatile("" : "+s"(b_.bar), "+s"(b_.x)); xcd_barrier(b_, wave == 0 && lane_id() == 0); } while (0)
#define OPAQUE_TID(t) int t = wave * 64 + lane_id(); asm volatile("" : "+v"(t))
#ifndef REP_PRO
#define REP_PRO 1
#endif
    for (int rep = 0; rep < REP_PRO; ++rep) { OPAQUE_TID(tid); p0_prologue(args, L, bid, G, tid, wave, tid & 63); __syncthreads(); }
    if (args.cg_seam) grid.sync(); else GRID_BAR();
    if (threadIdx.x == 0) { bool ok = (G == 256); for (int x = 0; x < 8; ++x) ok = ok && (xb_ld((unsigned*)(ws + WS_CTL) + CW_XR + 64 * x) == 32u);
        MISC[18] = ok ? MISC[16] * 32u + MISC[17] : 0xffffffffu; }
    __syncthreads();
    const int vcu = (int)__builtin_amdgcn_readfirstlane((int)MISC[18]);
    const bool grouped = (G == 256);
    const int v = (vcu >= 0) ? vcu : bid;
    unsigned gep = 0u;
#define SEAM() do { if (grouped) { ++gep; unsigned* c_ = (unsigned*)(ws + WS_CTL) + CW_GRP + 64 * (v >> 3); unsigned* b_ = (unsigned*)(ws + WS_CTL) + CW_BAR; asm volatile("" : "+s"(c_), "+s"(b_)); \
        group_barrier(b_, c_, 8u * gep, vcu >= 0, wave == 0 && lane_id() == 0); } else GRID_BAR(); } while (0)
    const int pb = grouped ? v : bid, pG = grouped ? 256 : G;
    for (int rep = 0; rep < REP_ROW; ++rep) { OPAQUE_TID(tid); prenorm0_phase(args, L, pb, pG, tid, wave, tid & 63); }
    SEAM();
    for (int l = 0; l < DEPTH; ++l) {
        for (int rep = 0; rep < REP_GEMM; ++rep) {
            OPAQUE_TID(tid);
            pg8::Gemm g{(const pg8::bf16_t*)(ws + WS_H), (const pg8::bf16_t*)(ws + WS_WIN) + (size_t)l * NU * D, MROWS, N_G1, D};
            pg8::EpiStoreGK E{(pg8::bf16_t*)(ws + WS_U), MROWS, D_IN, (float*)(ws + WS_KMACC) + (size_t)l * 131072};
            if (grouped) { pg8::GroupOrder<N_G1 / 256> S; S.init(v >> 3, v & 7); pg8::gemm_phase<pg8::EpiStoreGK, pg8::GroupOrder<N_G1 / 256>, true, true>(L, g, S, E, tid); }
            else { pg8::StaticOrder S; S.init(MROWS, N_G1, G, bid); pg8::gemm_phase<pg8::EpiStoreGK, pg8::StaticOrder, true, true>(L, g, S, E, tid); }
        }
        SEAM();
        for (int rep = 0; rep < REP_KC; ++rep) { OPAQUE_TID(tid); kmean_compress_phase(args, l, L, pb, pG, tid, wave, tid & 63); }
        SEAM();
        for (int rep = 0; rep < REP_ATT; ++rep)
        att::attn_phase((char*)lds, (const att::bf16_t*)(ws + WS_U), (const att::bf16_t*)(ws + WS_KMHL), (const att::bf16_t*)(ws + WS_KC), (att::bf16_t*)(ws + WS_Y), vcu, wave);
        SEAM();
        for (int rep = 0; rep < REP_GEMM; ++rep) {
            OPAQUE_TID(tid);
            pg8::Gemm g{(const pg8::bf16_t*)(ws + WS_Y), (const pg8::bf16_t*)(ws + WS_WOUT) + (size_t)l * D * D, MROWS, D, D};
            pg8::EpiStore E{(pg8::bf16_t*)(ws + WS_O), D, D};
            if (grouped) { pg8::OwnerOrder<D / 256> S; S.init(v >> 3, v & 7); pg8::gemm_phase<pg8::EpiStore, pg8::OwnerOrder<D / 256>, true, true>(L, g, S, E, tid); }
            else { pg8::StaticOrder S; S.init(MROWS, D, G, bid); pg8::gemm_phase<pg8::EpiStore, pg8::StaticOrder, true, true>(L, g, S, E, tid); }
        }
        if (grouped) { asm volatile("s_waitcnt vmcnt(0)" ::: "memory"); __syncthreads(); __builtin_amdgcn_fence(__ATOMIC_ACQUIRE, "agent"); } else GRID_BAR();
        for (int rep = 0; rep < (l == 0 ? REP_ROW : 1); ++rep) { OPAQUE_TID(tid); if (l == 0) postnorm_phase<0>(args, L, pb, pG, tid, wave, tid & 63); else postnorm_phase<1>(args, L, pb, pG, tid, wave, tid & 63); }
        if (l + 1 < DEPTH) SEAM();
    }
#undef SEAM
#undef OPAQUE_TID
#undef GRID_BAR
}

extern "C" void kernel_launch(void* const* d_in, const int* in_sizes, int n_in, void* d_out, int out_size, void* d_ws, size_t ws_size, hipStream_t stream) {
    static int grid = 0;
    if (grid == 0) {
        if (n_in != 14 || out_size != MROWS * D || ws_size < WS_END) { fprintf(stderr, "kernel_launch: unexpected shapes (n_in %d, out %d, ws %zu)\n", n_in, out_size, ws_size); grid = -1; return; }
        int dev = 0, cus = 0, per_cu = 0;
        hipGetDevice(&dev); hipDeviceGetAttribute(&cus, hipDeviceAttributeMultiprocessorCount, dev);
        if (hipFuncSetAttribute((const void*)hybrid_fwd, hipFuncAttributeMaxDynamicSharedMemorySize, LDS_BYTES) != hipSuccess) { fprintf(stderr, "kernel_launch: hipFuncSetAttribute failed\n"); grid = -1; return; }
        if (hipOccupancyMaxActiveBlocksPerMultiprocessor(&per_cu, (const void*)hybrid_fwd, NWAVES * 64, LDS_BYTES) != hipSuccess || per_cu < 1) { fprintf(stderr, "kernel_launch: occupancy query says %d blocks per CU\n", per_cu); per_cu = 1; }
        (void)hipGetLastError();
        grid = cus;
    }
    if (grid < 0) return;
    hipMemsetAsync((char*)d_ws + WS_CTL, 0, CTL_ZERO_BYTES, stream);
    Args a{};
    for (int i = 0; i < 14; ++i) a.in[i] = (const float*)d_in[i];
    a.out = (float*)d_out; a.ws = (unsigned char*)d_ws;
    void* kargs[] = {&a};
    hipError_t e = hipLaunchCooperativeKernel((const void*)hybrid_fwd, dim3(grid), dim3(NWAVES * 64), kargs, LDS_BYTES, stream);
    if (e != hipSuccess) fprintf(stderr, "kernel_launch: cooperative launch failed: %s (grid %d)\n", hipGetErrorString(e), grid);
}
```

```cpp
#include <hip/hip_runtime.h>
#include <hip/hip_cooperative_groups.h>
#include <hip/hip_bf16.h>
#include <cstdio>
#include <cstdint>
#include <cmath>
namespace cg = cooperative_groups;
namespace pg8 {
#define PG8_LAS __attribute__((address_space(3)))
typedef unsigned short bf16_t;
typedef short bf16x8 __attribute__((ext_vector_type(8)));
typedef float f32x4 __attribute__((ext_vector_type(4)));
typedef unsigned u32x4 __attribute__((ext_vector_type(4)));
constexpr int BM = 256, BK = 64, HALF = 128, HTB = HALF * BK * 2  , STAGE_BYTES = 8 * HTB, NXCD = 8, WGM = 8;

__host__ __device__ __forceinline__ int lds_byte(int r, int c) { const int st = (r >> 4) * 2 + (c >> 5), rr = r & 15, cc = c & 31, ob = rr * 64 + cc * 2; return st * 1024 + (ob ^ (((ob >> 9) & 1) << 5)); }
__host__ __device__ __forceinline__ void stage_rc(int b, int& R, int& C) { const int st = b / 1024, sb = b % 1024, swz = sb ^ (((sb >> 9) & 1) << 5); R = (st >> 1) * 16 + swz / 64; C = (st & 1) * 32 + (swz % 64) / 2; }
__host__ __device__ __forceinline__ int perm32(int rho) { const int n = rho >> 4, i = rho & 15; return 8 * (i >> 2) + 4 * n + (i & 3); }

struct Unit { int pm, pn; };
struct Gemm { const bf16_t* A; const bf16_t* Bt; int M, N, K; };

struct StaticOrder {
    int nM, nN, nwg, G, c;
    __host__ __device__ void init(int M, int N, int G_, int c_) { nM = M / BM; nN = N / BM; nwg = nM * nN; G = G_; c = c_; }
    __host__ __device__ bool next(int i, Unit& u) const {
        const long L = (long)i * G + c; if (L >= nwg) return false;
        int wgid = (int)L; { const int q = nwg / NXCD, r = nwg % NXCD, xcd = wgid % NXCD, off = wgid / NXCD; wgid = (xcd < r ? xcd * (q + 1) : r * (q + 1) + (xcd - r) * q) + off; }
        const int nig = WGM * nN, gid = wgid / nig, fm = gid * WGM, gsz = (nM - fm) < WGM ? (nM - fm) : WGM;
        u.pm = fm + ((wgid % nig) % gsz); u.pn = (wgid % nig) / gsz; return true;
    }
    __device__ __forceinline__ void a_ready(const Unit&) const {}
    __device__ __forceinline__ void done(const Unit&) const {}
};
template <int NN>
struct GroupOrder {
    int b, j;
    __host__ __device__ void init(int b_, int j_) { b = b_; j = j_; }
    __host__ __device__ bool next(int i, Unit& u) const { const int t = 8 * i + j; if (t >= 8 * NN) return false; u.pm = 8 * b + t / NN; u.pn = t % NN; return true; }
    __device__ __forceinline__ void a_ready(const Unit&) const {}
    __device__ __forceinline__ void done(const Unit&) const {}
};
template <int NN>
struct OwnerOrder {
    int b, j;
    __host__ __device__ void init(int b_, int j_) { b = b_; j = j_; }
    __host__ __device__ bool next(int i, Unit& u) const { if (i >= NN) return false; u.pm = 8 * b + j; u.pn = i; return true; }
    __device__ __forceinline__ void a_ready(const Unit&) const {}
    __device__ __forceinline__ void done(const Unit&) const {}
};
__device__ __forceinline__ unsigned cvt_pk_bf16(float lo, float hi) { unsigned r; asm volatile("v_cvt_pk_bf16_f32 %0, %1, %2" : "=v"(r) : "v"(lo), "v"(hi)); return r; }
struct EpiStore {
    static constexpr bool PERM = true, AFTER_DRAIN = false, ZEROES = true;
    bf16_t* O; int ldc; int ncols;
    __device__ __forceinline__ void operator()(f32x4 (&acc)[2][2][4][2], const Unit& u, int wr, int wc, int fr, int fq) const {
        const int row0 = u.pm * BM + wr * 64 + fr; const int col0 = u.pn * BM + wc * 32 + 8 * fq;
#pragma unroll
        for (int ai = 0; ai < 2; ++ai)
#pragma unroll
            for (int m = 0; m < 4; ++m) { bf16_t* rowp = O + (size_t)(row0 + ai * HALF + m * 16) * ldc + col0;
#pragma unroll
                for (int bj = 0; bj < 2; ++bj) { const f32x4 v0 = acc[ai][bj][m][0], v1 = acc[ai][bj][m][1];
                    u32x4 w; w.x = cvt_pk_bf16(v0[0], v0[1]); w.y = cvt_pk_bf16(v0[2], v0[3]); w.z = cvt_pk_bf16(v1[0], v1[1]); w.w = cvt_pk_bf16(v1[2], v1[3]);
                    if (col0 + bj * HALF < ncols) *(u32x4*)(rowp + bj * HALF) = w;
                    acc[ai][bj][m][0] = (f32x4){0.f, 0.f, 0.f, 0.f}; acc[ai][bj][m][1] = (f32x4){0.f, 0.f, 0.f, 0.f}; __builtin_amdgcn_sched_barrier(0); } }
    }
};

struct EpiStoreG {
    static constexpr bool PERM = true, AFTER_DRAIN = false, ZEROES = false;
    bf16_t* O; int M; int ncols;
    __device__ __forceinline__ void operator()(const f32x4 (&acc)[2][2][4][2], const Unit& u, int wr, int wc, int fr, int fq) const {
        const int row0 = u.pm * BM + wr * 64 + fr; const int col0 = u.pn * BM + wc * 32 + 8 * fq;
#pragma unroll
        for (int bj = 0; bj < 2; ++bj) { const int col = col0 + bj * HALF; bf16_t* cp = O + ((size_t)(col >> 6) * M + row0) * 64 + (col & 63);
            if (col < ncols) {
#pragma unroll
                for (int ai = 0; ai < 2; ++ai)
#pragma unroll
                    for (int m = 0; m < 4; ++m) { const f32x4 v0 = acc[ai][bj][m][0], v1 = acc[ai][bj][m][1];
                        u32x4 w; w.x = cvt_pk_bf16(v0[0], v0[1]); w.y = cvt_pk_bf16(v0[2], v0[3]); w.z = cvt_pk_bf16(v1[0], v1[1]); w.w = cvt_pk_bf16(v1[2], v1[3]);
                        *(u32x4*)(cp + (size_t)(ai * HALF + m * 16) * 64) = w; } } }
    }
};

__device__ __forceinline__ float row16_sum(float v) {
    v += __builtin_bit_cast(float, __builtin_amdgcn_update_dpp(0, __builtin_bit_cast(int, v), 0xB1, 0xF, 0xF, true));
    v += __builtin_bit_cast(float, __builtin_amdgcn_update_dpp(0, __builtin_bit_cast(int, v), 0x4E, 0xF, 0xF, true));
    v += __builtin_bit_cast(float, __builtin_amdgcn_update_dpp(0, __builtin_bit_cast(int, v), 0x141, 0xF, 0xF, true));
    v += __builtin_bit_cast(float, __builtin_amdgcn_update_dpp(0, __builtin_bit_cast(int, v), 0x140, 0xF, 0xF, true));
    return v;
}
struct EpiStoreGK {
    static constexpr bool PERM = true, AFTER_DRAIN = false, ZEROES = true;
    bf16_t* O; int M; int ncols; float* KM;
    __device__ __forceinline__ void operator()(f32x4 (&acc)[2][2][4][2], const Unit& u, int wr, int wc, int fr, int fq) const {
        const int row0 = u.pm * BM + wr * 64 + fr; const int col0 = u.pn * BM + wc * 32 + 8 * fq;
        if ((u.pn >> 1) == 1) {
            float* kmb = KM + (size_t)(((u.pm >> 3) * 8) * 8 + (u.pm & 7)) * 64;
#pragma unroll
            for (int bj = 0; bj < 2; ++bj) { const int kcol = col0 + bj * HALF - 512;
                float* dst = kmb + (size_t)(kcol >> 6) * 512 + (kcol & 63);
#pragma unroll
                for (int h2 = 0; h2 < 2; ++h2)
#pragma unroll
                    for (int e = 0; e < 4; ++e) { float s = 0.f;
#pragma unroll
                        for (int ai = 0; ai < 2; ++ai)
#pragma unroll
                            for (int m = 0; m < 4; ++m) s += acc[ai][bj][m][h2][e];
                        s = row16_sum(s);
                        if (fr == 0) atomicAdd(dst + 4 * h2 + e, s); } }
        }
#pragma unroll
        for (int bj = 0; bj < 2; ++bj) { const int col = col0 + bj * HALF; bf16_t* cp = O + ((size_t)(col >> 6) * M + row0) * 64 + (col & 63);
#pragma unroll
            for (int ai = 0; ai < 2; ++ai)
#pragma unroll
                for (int m = 0; m < 4; ++m) { const f32x4 v0 = acc[ai][bj][m][0], v1 = acc[ai][bj][m][1];
                    u32x4 w; w.x = cvt_pk_bf16(v0[0], v0[1]); w.y = cvt_pk_bf16(v0[2], v0[3]); w.z = cvt_pk_bf16(v1[0], v1[1]); w.w = cvt_pk_bf16(v1[2], v1[3]);
                    if (col < ncols) *(u32x4*)(cp + (size_t)(ai * HALF + m * 16) * 64) = w;
                    acc[ai][bj][m][0] = (f32x4){0.f, 0.f, 0.f, 0.f}; acc[ai][bj][m][1] = (f32x4){0.f, 0.f, 0.f, 0.f}; __builtin_amdgcn_sched_barrier(0); } }
    }
};

template <class Epi, class Sched, bool ALIGN_EPI = false, bool SP2 = false>
__device__ __forceinline__ void gemm_phase(PG8_LAS unsigned char* lds, const Gemm g, const Sched& S, const Epi& E, const int tid) {
    const int wid = __builtin_amdgcn_readfirstlane(tid >> 6), lane = tid & 63, wr = wid >> 2, wc = wid & 3, fr = lane & 15, fq = lane >> 4;
    const int K = g.K, nt = K / BK;
    unsigned voffA[2], voffB[2];
#pragma unroll
    for (int i = 0; i < 2; ++i) { int R, C; stage_rc(tid * 16 + i * 8192, R, C); const int Rb = Epi::PERM ? ((R & ~31) + perm32(R & 31)) : R;
        voffA[i] = (unsigned)(R * K + C) * 2u; voffB[i] = (unsigned)(Rb * K + C) * 2u; }
    const size_t kstep = (size_t)(BK * 2);
    const size_t hstep = (size_t)HALF * K * 2;
    const size_t tstep = 2 * hstep;
    const unsigned ldsw = (unsigned)wid * 1024u;
    const int aoff = lds_byte(wr * 64 + fr, fq * 8), boff = lds_byte(wc * 32 + fr, fq * 8);
#define PG8_SA(b, h) (((b) * 2 + (h)) * HTB)
#define PG8_SB(b, h) ((4 + (b) * 2 + (h)) * HTB)
#define PG8_STAGE(bufoff, gbase, voff) do { _Pragma("unroll") for (int _i = 0; _i < 2; ++_i) \
        __builtin_amdgcn_global_load_lds((const unsigned*)((const char*)(gbase) + (voff)[_i]), (PG8_LAS unsigned*)(lds + (bufoff) + ldsw + _i * 8192), 16, 0, 0); } while (0)
#define PG8_LDA(dst, b, h) do { _Pragma("unroll") for (int m = 0; m < 4; ++m) _Pragma("unroll") for (int k = 0; k < 2; ++k) dst[m][k] = *(const PG8_LAS bf16x8*)(lds + PG8_SA(b, h) + aoff + m * 2048 + k * 1024); } while (0)
#define PG8_LDB(dst, b, h) do { _Pragma("unroll") for (int n = 0; n < 2; ++n) _Pragma("unroll") for (int k = 0; k < 2; ++k) dst[n][k] = *(const PG8_LAS bf16x8*)(lds + PG8_SB(b, h) + boff + n * 2048 + k * 1024); } while (0)
#define PG8_MMA(ai, bj, At, Bt) do { __builtin_amdgcn_s_setprio(1); _Pragma("unroll") for (int m = 0; m < 4; ++m) _Pragma("unroll") for (int n = 0; n < 2; ++n) _Pragma("unroll") for (int k = 0; k < 2; ++k) \
        acc[ai][bj][m][n] = __builtin_amdgcn_mfma_f32_16x16x32_bf16(Bt[n][k], At[m][k], acc[ai][bj][m][n], 0, 0, 0); __builtin_amdgcn_s_setprio(0); } while (0)
#define PG8_WAIT_V(n) asm volatile("s_waitcnt vmcnt(" #n ")" ::: "memory")
#define PG8_WAIT_L(n) asm volatile("s_waitcnt lgkmcnt(" #n ")" ::: "memory")
#define PG8_BAR __builtin_amdgcn_s_barrier()
#define PG8_SCHED __builtin_amdgcn_sched_barrier(0)
    Unit cur, nxt; int ui = 0;
    if (!S.next(0, cur)) return;
    f32x4 acc[2][2][4][2];
#pragma unroll
    for (int a = 0; a < 2; ++a)
#pragma unroll
        for (int b = 0; b < 2; ++b)
#pragma unroll
            for (int m = 0; m < 4; ++m)
#pragma unroll
                for (int n = 0; n < 2; ++n) acc[a][b][m][n] = (f32x4){0.f, 0.f, 0.f, 0.f};
    bf16x8 At[4][2], B0[2][2], B1[2][2];
    const char* cA = (const char*)g.A + (size_t)cur.pm * tstep; const char* cB = (const char*)g.Bt + (size_t)cur.pn * tstep;
    S.a_ready(cur);
    if constexpr (SP2) {
        PG8_STAGE(PG8_SB(0, 0), cB, voffB); PG8_STAGE(PG8_SB(0, 1), cB + hstep, voffB); PG8_STAGE(PG8_SA(0, 0), cA, voffA); PG8_STAGE(PG8_SA(0, 1), cA + hstep, voffA);
        if (wr == 1) PG8_BAR;
        PG8_WAIT_V(2); PG8_BAR;
        PG8_STAGE(PG8_SB(1, 0), cB + kstep, voffB); PG8_STAGE(PG8_SA(1, 0), cA + kstep, voffA); PG8_STAGE(PG8_SB(1, 1), cB + hstep + kstep, voffB);
        PG8_WAIT_V(6); PG8_BAR;
    } else {
        PG8_STAGE(PG8_SB(0, 0), cB, voffB); PG8_STAGE(PG8_SA(0, 0), cA, voffA); PG8_STAGE(PG8_SB(0, 1), cB + hstep, voffB); PG8_STAGE(PG8_SA(0, 1), cA + hstep, voffA);
        if (wr == 1) PG8_BAR;
        PG8_WAIT_V(4); PG8_BAR;
        PG8_STAGE(PG8_SB(1, 0), cB + kstep, voffB); PG8_STAGE(PG8_SA(1, 0), cA + kstep, voffA); PG8_STAGE(PG8_SB(1, 1), cB + hstep + kstep, voffB);
        PG8_WAIT_V(6); PG8_BAR;
    }
    for (;;) {
        const bool has_next = S.next(ui + 1, nxt);
        const char* nA = has_next ? (const char*)g.A + (size_t)nxt.pm * tstep : cA; const char* nB = has_next ? (const char*)g.Bt + (size_t)nxt.pn * tstep : cB;
        for (int t = 0; t < nt; t += 2) {
            const bool last = (t == nt - 2);
            const char* a1 = cA + (size_t)(t + 1) * kstep;
            const char* a2 = last ? nA : cA + (size_t)(t + 2) * kstep; const char* b2 = last ? nB : cB + (size_t)(t + 2) * kstep;
            const char* a3 = a2 + kstep; const char* b3 = b2 + kstep;
            if (last && has_next) S.a_ready(nxt);
            if constexpr (SP2) {
            int uio_ = ui; asm volatile("" : "+s"(uio_));
            int tz_ = t; asm volatile("" : "+s"(tz_));
            const bool after_epi = (tz_ == 0) && (uio_ > 0);
            PG8_LDB(B0, 0, 0); PG8_LDB(B1, 0, 1); PG8_SCHED; PG8_LDA(At, 0, 0); PG8_STAGE(PG8_SA(1, 1), a1 + hstep, voffA);
            if (after_epi) PG8_WAIT_V(24); else PG8_WAIT_V(8);
            PG8_WAIT_L(0); PG8_BAR; PG8_MMA(0, 0, At, B0); PG8_MMA(0, 1, At, B1); PG8_BAR; PG8_SCHED;
            PG8_LDA(At, 0, 1); PG8_STAGE(PG8_SB(0, 0), b2, voffB); PG8_STAGE(PG8_SB(0, 1), b2 + hstep, voffB); PG8_STAGE(PG8_SA(0, 0), a2, voffA);
            if (after_epi) PG8_WAIT_V(24); else PG8_WAIT_V(8);
            PG8_WAIT_L(0); PG8_BAR; PG8_MMA(1, 0, At, B0); PG8_MMA(1, 1, At, B1); PG8_BAR; PG8_SCHED;
            PG8_LDB(B0, 1, 0); PG8_LDB(B1, 1, 1); PG8_SCHED; PG8_LDA(At, 1, 0); PG8_STAGE(PG8_SA(0, 1), a2 + hstep, voffA);
            PG8_WAIT_V(8); PG8_WAIT_L(0); PG8_BAR; PG8_MMA(0, 0, At, B0); PG8_MMA(0, 1, At, B1); PG8_BAR; PG8_SCHED;
            PG8_LDA(At, 1, 1); PG8_STAGE(PG8_SB(1, 0), b3, voffB); PG8_STAGE(PG8_SB(1, 1), b3 + hstep, voffB); PG8_STAGE(PG8_SA(1, 0), a3, voffA);
            PG8_WAIT_V(8); PG8_WAIT_L(0); PG8_BAR; PG8_MMA(1, 0, At, B0); PG8_MMA(1, 1, At, B1); PG8_BAR; PG8_SCHED;
            } else {
            PG8_LDB(B0, 0, 0); PG8_SCHED; PG8_LDA(At, 0, 0); PG8_STAGE(PG8_SA(1, 1), a1 + hstep, voffA);
            PG8_WAIT_L(8); PG8_BAR; PG8_WAIT_L(0); PG8_MMA(0, 0, At, B0); PG8_BAR; PG8_SCHED;
            PG8_LDB(B1, 0, 1); PG8_STAGE(PG8_SB(0, 0), b2, voffB);
            PG8_BAR; PG8_WAIT_L(0); PG8_MMA(0, 1, At, B1); PG8_BAR;
            PG8_LDA(At, 0, 1); PG8_STAGE(PG8_SA(0, 0), a2, voffA);
            PG8_BAR; PG8_WAIT_L(0); PG8_MMA(1, 0, At, B0); PG8_BAR; PG8_SCHED;
            PG8_STAGE(PG8_SB(0, 1), b2 + hstep, voffB);
            PG8_WAIT_V(6); PG8_BAR; PG8_MMA(1, 1, At, B1); PG8_BAR;
            PG8_LDB(B0, 1, 0); PG8_SCHED; PG8_LDA(At, 1, 0); PG8_STAGE(PG8_SA(0, 1), a2 + hstep, voffA);
            PG8_WAIT_L(8); PG8_BAR; PG8_WAIT_L(0); PG8_MMA(0, 0, At, B0); PG8_BAR; PG8_SCHED;
            PG8_LDB(B1, 1, 1); PG8_STAGE(PG8_SB(1, 0), b3, voffB);
            PG8_BAR; PG8_WAIT_L(0); PG8_MMA(0, 1, At, B1); PG8_BAR;
            PG8_LDA(At, 1, 1); PG8_STAGE(PG8_SA(1, 0), a3, voffA);
            PG8_BAR; PG8_WAIT_L(0); PG8_MMA(1, 0, At, B0); PG8_BAR; PG8_SCHED;
            PG8_STAGE(PG8_SB(1, 1), b3 + hstep, voffB);
            PG8_WAIT_V(6); PG8_BAR; PG8_MMA(1, 1, At, B1); PG8_BAR;
            }
        }
        if constexpr (ALIGN_EPI) { if (wr == 0) PG8_BAR; }
        if constexpr (!Epi::AFTER_DRAIN) { E(acc, cur, wr, wc, fr, fq); S.done(cur); }
        if (!has_next) break;
        if constexpr (!Epi::ZEROES)
#pragma unroll
        for (int a = 0; a < 2; ++a)
#pragma unroll
            for (int b = 0; b < 2; ++b)
#pragma unroll
                for (int m = 0; m < 4; ++m)
#pragma unroll
                    for (int n = 0; n < 2; ++n) acc[a][b][m][n] = (f32x4){0.f, 0.f, 0.f, 0.f};
        cur = nxt; cA = nA; cB = nB; ++ui;
        if constexpr (ALIGN_EPI) { if (wr == 1) PG8_BAR; }
    }
    PG8_WAIT_V(0);
    if constexpr (!ALIGN_EPI) { if (wr == 0) PG8_BAR; }
    PG8_BAR;
    if constexpr (Epi::AFTER_DRAIN) { E.fused(acc, cur, wr, wc, fr, fq, lds, wid, lane); S.done(cur); }
#undef PG8_SA
#undef PG8_SB
#undef PG8_STAGE
#undef PG8_LDA
#undef PG8_LDB
#undef PG8_MMA
#undef PG8_WAIT_V
#undef PG8_WAIT_L
#undef PG8_BAR
#undef PG8_SCHED
}
}
namespace att {
using bf16x8 = __attribute__((ext_vector_type(8))) short;
using s16x4 = __attribute__((ext_vector_type(4))) short;
using f32x16 = __attribute__((ext_vector_type(16))) float;
using u32x4 = __attribute__((ext_vector_type(4))) unsigned;
typedef unsigned short bf16_t;
#define ALAS __attribute__((address_space(3)))
typedef ALAS const char* lds_cptr;
typedef short v4i16_t __attribute__((ext_vector_type(4)));
constexpr int UP = 64;
constexpr int MR = 65536;
constexpr int YP = 1024;
constexpr int SEQ = 2048;
constexpr int SLOTB = 8192;
constexpr int RD = 3, KA = RD + 2, VA = RD + 1, NKS = KA + 1, NVS = VA + 1;
constexpr int LDS_K = 0, LDS_V = NKS * SLOTB, LDS_WS = (NKS + NVS) * SLOTB, LDS_RM = LDS_WS + 8 * 256, LDS_WQ = LDS_RM + 256, LDS_OST = LDS_WQ + 256, LDS_IMP = LDS_OST + 8 * 4096, LDS_END = LDS_IMP + 4 * 64 * 33 * 4;
static_assert(LDS_IMP + 4 * 64 * 33 * 4 >= LDS_OST + 8 * 8192, "per-wave park region");
constexpr int LDS_TAB = LDS_END;
static_assert(LDS_TAB + 56 * 16 <= 163840 - 256, "step table below the frame's last 256 bytes");
constexpr float LOG2E = 1.4426950408889634f;
constexpr float THR = 6.0f;
constexpr float NEGINF = -INFINITY;
constexpr int C_QM = 0, C_KM = 512, C_VM = 1024, C_ZM = 1536, C_QN = 2048, C_KC = 2560, C_VC = 2688, C_KS = 2816, C_VS = 2944, C_KW = 3072, C_VW = 3200, C_ZN = 3328, C_GL = 3840;

__device__ __forceinline__ const unsigned short* ucol(const unsigned short* U, int col) { return U + (size_t)(col >> 6) * MR * 64 + (col & 63); }
__device__ __forceinline__ int crow(int r, int hi) { return (r & 3) + 8 * (r >> 2) + 4 * hi; }
__device__ __forceinline__ float bf2f(bf16_t v) { return __uint_as_float((unsigned)v << 16); }
__device__ __forceinline__ void glds16(const void* gsrc, unsigned lds_dst) { unsigned keep;
  asm volatile("s_mov_b32 %0, m0\n\ts_mov_b32 m0, %2\n\ts_nop 0\n\tglobal_load_lds_dwordx4 %1, off\n\ts_mov_b32 m0, %0" : "=&s"(keep) : "v"(gsrc), "s"(lds_dst) : "memory"); }
typedef float f32x2_t __attribute__((ext_vector_type(2))); typedef __bf16 bf16x2_t __attribute__((ext_vector_type(2)));
__device__ __forceinline__ unsigned cvtpk(float lo, float hi) { f32x2_t v = {lo, hi}; bf16x2_t b = __builtin_convertvector(v, bf16x2_t); return __builtin_bit_cast(unsigned, b); }
#define AT_WAIT_BAR() asm volatile("s_waitcnt vmcnt(0) lgkmcnt(0)\n\ts_barrier" ::: "memory")
#define AT_SBAR() __builtin_amdgcn_sched_barrier(0)
struct KAddr { lds_cptr a[4]; };
__device__ __forceinline__ void kload8(bf16x8* kf, const KAddr& ka, int slotoff) {
#pragma unroll
  for (int d0 = 0; d0 < 4; ++d0) { kf[2 * d0] = *(const ALAS bf16x8*)(ka.a[d0] + slotoff); kf[2 * d0 + 1] = *(const ALAS bf16x8*)(ka.a[d0] + slotoff + 4096); }
}
__device__ __forceinline__ void qkt(f32x16& p0, f32x16& p1, const KAddr& ka, int slotoff, const bf16x8* qr) {
  bf16x8 kf[8]; kload8(kf, ka, slotoff);
  p0 = f32x16{}; p1 = f32x16{};
#pragma unroll
  for (int d0 = 0; d0 < 4; ++d0) {
    p0 = __builtin_amdgcn_mfma_f32_32x32x16_bf16(kf[2 * d0], qr[d0], p0, 0, 0, 0);
    p1 = __builtin_amdgcn_mfma_f32_32x32x16_bf16(kf[2 * d0 + 1], qr[d0], p1, 0, 0, 0);
  }
}
__device__ __forceinline__ float rowmax32(const f32x16& p0, const f32x16& p1) {
  float a = fmaxf(p0[0], p1[0]);
#pragma unroll
  for (int r = 1; r < 16; ++r) a = fmaxf(a, fmaxf(p0[r], p1[r]));
  return fmaxf(a, __shfl_xor(a, 32));
}
__device__ __forceinline__ void pv(f32x16* o, int vb, bf16x8 pa0, bf16x8 pa1, bf16x8 pa2, bf16x8 pa3) {
#pragma unroll
  for (int d0 = 0; d0 < 2; ++d0) { s16x4 lo[4], hi[4];
#pragma unroll
    for (int ks = 0; ks < 4; ++ks) {
      asm volatile("ds_read_b64_tr_b16 %0,%1 offset:%c2" : "=&v"(lo[ks]) : "v"(vb), "i"(d0 * 4096 + ks * 1024) : "memory");
      asm volatile("ds_read_b64_tr_b16 %0,%1 offset:%c2" : "=&v"(hi[ks]) : "v"(vb), "i"(d0 * 4096 + ks * 1024 + 512) : "memory"); }
    asm volatile("s_waitcnt lgkmcnt(0)" ::: "memory"); AT_SBAR();
#define AT_PK(k) (bf16x8){lo[k][0], lo[k][1], lo[k][2], lo[k][3], hi[k][0], hi[k][1], hi[k][2], hi[k][3]}
    o[d0] = __builtin_amdgcn_mfma_f32_32x32x16_bf16(pa0, AT_PK(0), o[d0], 0, 0, 0);
    o[d0] = __builtin_amdgcn_mfma_f32_32x32x16_bf16(pa1, AT_PK(1), o[d0], 0, 0, 0);
    o[d0] = __builtin_amdgcn_mfma_f32_32x32x16_bf16(pa2, AT_PK(2), o[d0], 0, 0, 0);
    o[d0] = __builtin_amdgcn_mfma_f32_32x32x16_bf16(pa3, AT_PK(3), o[d0], 0, 0, 0);
#undef AT_PK
  }
}
__device__ __forceinline__ void pack_p(const f32x16& p0, const f32x16& p1, float s, bf16x8& a0, bf16x8& a1, bf16x8& a2, bf16x8& a3) {
  u32x4 w0 = {cvtpk(p0[0] * s, p0[1] * s), cvtpk(p0[2] * s, p0[3] * s), cvtpk(p0[4] * s, p0[5] * s), cvtpk(p0[6] * s, p0[7] * s)};
  u32x4 w1 = {cvtpk(p0[8] * s, p0[9] * s), cvtpk(p0[10] * s, p0[11] * s), cvtpk(p0[12] * s, p0[13] * s), cvtpk(p0[14] * s, p0[15] * s)};
  u32x4 w2 = {cvtpk(p1[0] * s, p1[1] * s), cvtpk(p1[2] * s, p1[3] * s), cvtpk(p1[4] * s, p1[5] * s), cvtpk(p1[6] * s, p1[7] * s)};
  u32x4 w3 = {cvtpk(p1[8] * s, p1[9] * s), cvtpk(p1[10] * s, p1[11] * s), cvtpk(p1[12] * s, p1[13] * s), cvtpk(p1[14] * s, p1[15] * s)};
  a0 = __builtin_bit_cast(bf16x8, w0); a1 = __builtin_bit_cast(bf16x8, w1); a2 = __builtin_bit_cast(bf16x8, w2); a3 = __builtin_bit_cast(bf16x8, w3);
}
__device__ __forceinline__ void pack_p1(const f32x16& p0, const f32x16& p1, bf16x8& a0, bf16x8& a1, bf16x8& a2, bf16x8& a3) {
  u32x4 w0 = {cvtpk(p0[0], p0[1]), cvtpk(p0[2], p0[3]), cvtpk(p0[4], p0[5]), cvtpk(p0[6], p0[7])};
  u32x4 w1 = {cvtpk(p0[8], p0[9]), cvtpk(p0[10], p0[11]), cvtpk(p0[12], p0[13]), cvtpk(p0[14], p0[15])};
  u32x4 w2 = {cvtpk(p1[0], p1[1]), cvtpk(p1[2], p1[3]), cvtpk(p1[4], p1[5]), cvtpk(p1[6], p1[7])};
  u32x4 w3 = {cvtpk(p1[8], p1[9]), cvtpk(p1[10], p1[11]), cvtpk(p1[12], p1[13]), cvtpk(p1[14], p1[15])};
  a0 = __builtin_bit_cast(bf16x8, w0); a1 = __builtin_bit_cast(bf16x8, w1); a2 = __builtin_bit_cast(bf16x8, w2); a3 = __builtin_bit_cast(bf16x8, w3);
}

struct Ctx {
  char* shm; unsigned lds0; int lane, r32, hi, wid;
  KAddr ka; int vb0; float* wsf;
  int koff, voff;
};
__device__ __forceinline__ void dma_tile(const Ctx& c, const bf16_t* Kb, const bf16_t* Vb, int pitch, int krow0, int slot) {
  const int krow = 8 * c.wid + (c.lane >> 3); const bf16_t* ks = Kb + (size_t)(krow0 + krow) * pitch + (((c.lane & 7) ^ ((krow >> 1) & 7)) << 3);
  const bf16_t* vs = Vb + (size_t)(krow0 + 16 * (c.wid & 3) + (c.lane >> 2)) * pitch + (c.wid >> 2) * 32 + (c.lane & 3) * 8;
  glds16(ks, (unsigned)__builtin_amdgcn_readfirstlane(c.lds0 + LDS_K + slot * SLOTB + c.wid * 1024));
  glds16(vs, (unsigned)__builtin_amdgcn_readfirstlane(c.lds0 + LDS_V + slot * SLOTB + c.wid * 1024));
}

__device__ __forceinline__ void dma_k(const Ctx& c, const bf16_t* Kb, int pitch, int krow0, int slot) {
  const int krow = 8 * c.wid + (c.lane >> 3);
  glds16(Kb + (size_t)(krow0 + krow) * pitch + (((c.lane & 7) ^ ((krow >> 1) & 7)) << 3), (unsigned)__builtin_amdgcn_readfirstlane(c.lds0 + LDS_K + slot * SLOTB + c.wid * 1024)); }
__device__ __forceinline__ void dma_v(const Ctx& c, const bf16_t* Vb, int pitch, int krow0, int slot) {
  const int vrow = 8 * c.wid + (c.lane >> 3), jp = c.lane & 7, j = ((((jp >> 1) ^ (((vrow >> 1) & 1) << 1)) << 1) | (jp & 1));
  glds16(Vb + (size_t)(krow0 + vrow) * pitch + j * 8, (unsigned)__builtin_amdgcn_readfirstlane(c.lds0 + LDS_V + slot * SLOTB + c.wid * 1024)); }
__device__ __forceinline__ void dma_k_off(const Ctx& c, const bf16_t* U, int off, int slot) {
  glds16((const char*)U + (long)off + c.koff, (unsigned)__builtin_amdgcn_readfirstlane(c.lds0 + LDS_K + slot * SLOTB + c.wid * 1024)); }
__device__ __forceinline__ void dma_v_off(const Ctx& c, const bf16_t* U, int off, int slot) {
  glds16((const char*)U + (long)off + c.voff, (unsigned)__builtin_amdgcn_readfirstlane(c.lds0 + LDS_V + slot * SLOTB + c.wid * 1024)); }
__device__ __forceinline__ float max3f(float a, float b, float c) { float r; asm("v_max3_f32 %0, %1, %2, %3" : "=v"(r) : "v"(a), "v"(b), "v"(c)); return r; }
__device__ __forceinline__ float max_halves(float a) { auto rr = __builtin_amdgcn_permlane32_swap(__float_as_uint(a), __float_as_uint(a), false, false); return fmaxf(__uint_as_float(rr[0]), __uint_as_float(rr[1])); }
__device__ __forceinline__ float sum_halves(float a) { auto rr = __builtin_amdgcn_permlane32_swap(__float_as_uint(a), __float_as_uint(a), false, false); return __uint_as_float(rr[0]) + __uint_as_float(rr[1]); }
__device__ __forceinline__ s16x4 vtr(lds_cptr p) { return __builtin_bit_cast(s16x4, __builtin_amdgcn_ds_read_tr16_b64_v4i16((ALAS v4i16_t*)p)); }

__device__ __forceinline__ void wait_bar_n(int n) {
  if (n >= 6) asm volatile("s_waitcnt vmcnt(6) lgkmcnt(0)\n\ts_barrier" ::: "memory");
  else if (n == 5) asm volatile("s_waitcnt vmcnt(5) lgkmcnt(0)\n\ts_barrier" ::: "memory");
  else if (n == 4) asm volatile("s_waitcnt vmcnt(4) lgkmcnt(0)\n\ts_barrier" ::: "memory");
  else if (n == 3) asm volatile("s_waitcnt vmcnt(3) lgkmcnt(0)\n\ts_barrier" ::: "memory");
  else if (n == 2) asm volatile("s_waitcnt vmcnt(2) lgkmcnt(0)\n\ts_barrier" ::: "memory");
  else if (n == 1) asm volatile("s_waitcnt vmcnt(1) lgkmcnt(0)\n\ts_barrier" ::: "memory");
  else asm volatile("s_waitcnt vmcnt(0) lgkmcnt(0)\n\ts_barrier" ::: "memory");
}
struct UnitP { int type, qi, n, nts; const bf16_t *k0, *k1, *k2;
  int npre; unsigned pre; unsigned remk, remv, remc;
  int ncmp; };
__device__ __forceinline__ int pop_lo(unsigned& m) { const int t = __builtin_ctz(m); m &= m - 1u; return t; }
constexpr long DV_M = (long)8 * MR * 64;
constexpr long DV_N = (long)2 * MR * 64;
constexpr long DV_C = 524288;
__device__ __forceinline__ void esrc(UnitP& u, int s, int which  , const bf16_t*& kp, const bf16_t*& vp, bool& hasv) {
  hasv = true;
  if (u.type == 0) {
    if (s == 0) { kp = u.k0; vp = u.k0; hasv = false; }
    else { const int tile = s < 5 ? 4 * u.qi + (s - 1) : s - 5; kp = u.k1 + (size_t)tile * 4096; vp = kp + DV_M; }
  } else {
    if (s < u.ncmp) { kp = u.k0 + s * 4096; vp = kp + DV_C; }
    else { const int j = s - u.ncmp;
      if (j < u.nts) { const int tile = (j < u.npre) ? (int)((u.pre >> (5 * j)) & 31u) : pop_lo(which == 0 ? u.remk : u.remv); kp = u.k1 + (size_t)tile * 4096; vp = kp + DV_N; }
      else { const int tile = u.qi - (j - u.nts); kp = u.k2 + (size_t)tile * 4096; vp = kp + DV_N; } }
  }
}
struct Ring { int ks, vs, c1, c2, pw; };
__device__ __forceinline__ int issue_pair(const Ctx& c, UnitP& u, int ek, int sk, int ev, int sv) {
  int cnt = 0; const bf16_t *kp, *vp; bool hv;
  if (ek < u.n) { esrc(u, ek, 0, kp, vp, hv); dma_k(c, kp, UP, 0, sk); ++cnt; }
  if (ev < u.n) { esrc(u, ev, 1, kp, vp, hv); if (hv) { dma_v(c, vp, UP, 0, sv); ++cnt; } }
  return cnt;
}
__device__ __forceinline__ void prologue_issue(const Ctx& c, UnitP& u, Ring& rg) {
  const bf16_t *kp, *vp; bool hv;
  esrc(u, 0, 0, kp, vp, hv); dma_k(c, kp, UP, 0, 0); if (hv) dma_v(c, vp, UP, 0, 0);
  if (u.n > 1) { esrc(u, 1, 0, kp, vp, hv); dma_k(c, kp, UP, 0, 1); }
  const int ca = issue_pair(c, u, 2, 2, 1, 1), cb = issue_pair(c, u, 3, 3, 2, 2), cc = issue_pair(c, u, 4, 4, 3, 3);
  rg.ks = 0; rg.vs = 0; rg.c1 = cc; rg.c2 = cb; rg.pw = ca + cb + cc;
}
__device__ __forceinline__ void prologue_wait(const Ctx& c, bf16x8* kf, const Ring& rg) {
  const int n = rg.pw + 8;
  if (n >= 14) asm volatile("s_waitcnt vmcnt(14) lgkmcnt(0)\n\ts_barrier" ::: "memory");
  else if (n >= 12) asm volatile("s_waitcnt vmcnt(12) lgkmcnt(0)\n\ts_barrier" ::: "memory");
  else if (n >= 10) asm volatile("s_waitcnt vmcnt(10) lgkmcnt(0)\n\ts_barrier" ::: "memory");
  else asm volatile("s_waitcnt vmcnt(8) lgkmcnt(0)\n\ts_barrier" ::: "memory");
  kload8(kf, c.ka, 0);
}
__device__ __forceinline__ void make_unit(UnitP& u, int type, int b, int hg, int qi, const bf16_t* U, const bf16_t* KMHL, const bf16_t* KC) {
  const size_t rowbase = (size_t)b * SEQ; u.type = type; u.qi = qi;
  if (type == 0) { u.n = 5 + 4 * qi; u.nts = 0; u.k0 = KMHL + (size_t)((b * 8 + hg) * 16) * 64; u.k1 = ucol(U, C_KM + hg * 64) + rowbase * UP; u.k2 = u.k1; }
  u.npre = 0; u.pre = 0u; u.remk = 0u; u.remv = 0u; u.remc = 0u; u.ncmp = 0;
  if (type != 0) {
    unsigned have = 0u, pk = 0u; int np = 0;
#define AT_PRE(t_) do { const int tt_ = (t_); if (tt_ >= 0) { if (!((have >> tt_) & 1u)) { have |= 1u << tt_; pk |= (unsigned)tt_ << (5 * np); ++np; } } } while (0)
    AT_PRE(qi); AT_PRE(qi - 1); AT_PRE(0); AT_PRE(qi - 2); AT_PRE(qi - 3);
#undef AT_PRE
    u.npre = np; u.pre = pk;
    const int nts = qi + 1, ntw = (qi < 8 ? qi : 8) + 1; u.ncmp = (qi < 16) ? 1 : 2; u.n = u.ncmp + nts + ntw; u.nts = nts;
    u.k0 = KC + (size_t)((b * 2 + hg) * 128) * 64; u.k1 = ucol(U, C_KS + hg * 64) + rowbase * UP; u.k2 = ucol(U, C_KW + hg * 64) + rowbase * UP;
  }
}
__device__ __forceinline__ const bf16_t* q_row(const Ctx& c, int type, int b, int hg, int qi, const bf16_t* U) {
  if (type == 0) return ucol(U, C_QM + hg * 64) + ((size_t)b * SEQ + 256 * qi + 32 * c.wid + c.r32) * UP;
  return ucol(U, C_QN + (hg * 4 + (c.wid >> 1)) * 64) + ((size_t)b * SEQ + 64 * qi + 32 * (c.wid & 1) + c.r32) * UP;
}
__device__ __forceinline__ int step_top(const Ctx& c, UnitP& u, int s, const Ring& rg) {
  return issue_pair(c, u, s + KA, rg.ks == 0 ? NKS - 1 : rg.ks - 1, s + VA, rg.vs == 0 ? NVS - 1 : rg.vs - 1);
}
__device__ __forceinline__ int next_k(const UnitP& u, int s, const Ring& rg) { (void)u; (void)s; return ((rg.ks + 1 == NKS) ? 0 : rg.ks + 1) * SLOTB; }
__device__ __forceinline__ void step_end(const Ctx& c, const UnitP& u, int s, int cnt, bf16x8* kf, Ring& rg, bool load = true) {
  __builtin_amdgcn_sched_barrier(0);
  const int ks1 = (rg.ks + 1 == NKS) ? 0 : rg.ks + 1;
  if (load && s + 1 < u.n) kload8(kf, c.ka, ks1 * SLOTB);
  wait_bar_n(cnt + rg.c1 + rg.c2);
  rg.c2 = rg.c1; rg.c1 = cnt; rg.ks = ks1; rg.vs = (rg.vs + 1 == NVS) ? 0 : rg.vs + 1;
}

template <int KST>
__device__ __forceinline__ void att_tile(const Ctx& c, int vs, bf16x8* kf, int knext  , const bf16x8* qr, float sk, float t0, int mode, int qx,
                                         float& m, float& l, f32x16* o, f32x16& p0, f32x16& p1) {
  const int vq = (c.lane & 15) >> 2, vx = (vq >> 1) & 1;
  const lds_cptr vpb = (lds_cptr)c.shm + LDS_V + vs * SLOTB + (4 * c.hi + vq) * 128 + ((c.lane >> 4) & 1) * 32 + (c.lane & 3) * 8;
  const lds_cptr vp0 = vpb + vx * 64, vp1 = vpb + (1 - vx) * 64;
  s16x4 vlo[8], vhi[8];
#pragma unroll
  for (int x = 0; x < 4; ++x) { vlo[x] = vtr(vp0 + x * 2048); vhi[x] = vtr(vp0 + x * 2048 + 1024); vlo[4 + x] = vtr(vp1 + x * 2048); vhi[4 + x] = vtr(vp1 + x * 2048 + 1024); }
  { typedef float f32x2v_ __attribute__((ext_vector_type(2)));
    const float sk8 = sk * 8.f, s32 = sk * 32.f; const f32x2v_ P01 = {0.f, sk}, P23 = {sk + sk, sk * 3.f};
    float bg = t0 - m;
#pragma unroll
    for (int g4 = 0; g4 < 4; ++g4) { const float bh = bg + s32;
      const f32x2v_ a_ = P01 + bg, b_ = P23 + bg, c_ = P01 + bh, d_ = P23 + bh;
      p0[4 * g4] = a_.x; p0[4 * g4 + 1] = a_.y; p0[4 * g4 + 2] = b_.x; p0[4 * g4 + 3] = b_.y;
      p1[4 * g4] = c_.x; p1[4 * g4 + 1] = c_.y; p1[4 * g4 + 2] = d_.x; p1[4 * g4 + 3] = d_.y;
      bg += sk8; } }
#pragma unroll
  for (int d0 = 0; d0 < 4; ++d0) {
    p0 = __builtin_amdgcn_mfma_f32_32x32x16_bf16(kf[2 * d0], qr[d0], p0, 0, 0, 0);
    p1 = __builtin_amdgcn_mfma_f32_32x32x16_bf16(kf[2 * d0 + 1], qr[d0], p1, 0, 0, 0);
  }
  kload8(kf, c.ka, knext);
  if (mode != 0) {
    if (mode == 1) {
#pragma unroll
      for (int r = 0; r < 16; ++r) { const int kc = KST * ((r & 3) + 8 * (r >> 2)); if (kc > qx) p0[r] = NEGINF; if (kc + 32 * KST > qx) p1[r] = NEGINF; }
    } else {
#pragma unroll
      for (int r = 0; r < 16; ++r) { const int kc = (r & 3) + 8 * (r >> 2); if (kc <= qx) p0[r] = NEGINF; if (kc + 32 <= qx) p1[r] = NEGINF; }
    }
  }
  asm volatile("s_nop 15\n\ts_nop 7" : "+v"(p0), "+v"(p1));
  float rm = max3f(p0[0], p1[0], p0[1]), rm2 = max3f(p1[1], p0[2], p1[2]);
#pragma unroll
  for (int r = 3; r < 15; r += 2) { rm = max3f(rm, p0[r], p1[r]); rm2 = max3f(rm2, p0[r + 1], p1[r + 1]); }
  rm = max3f(rm, rm2, p0[15]); rm = max3f(rm, p1[15], rm);
  rm = max_halves(rm);
  if (__any(rm > THR)) {
    const float dl = fmaxf(rm, 0.f); m += dl;
#pragma unroll
    for (int r = 0; r < 16; ++r) { p0[r] -= dl; p1[r] -= dl; }
    const float alpha = __builtin_amdgcn_exp2f(-dl); l *= alpha;
    if (c.hi == 0) c.wsf[c.r32] = alpha;
    asm volatile("s_waitcnt lgkmcnt(0)" ::: "memory");
#pragma unroll
    for (int r = 0; r < 16; ++r) { const float f = c.wsf[crow(r, c.hi)]; o[0][r] *= f; o[1][r] *= f; }
    asm volatile("s_waitcnt lgkmcnt(0)" ::: "memory");
  }
  float s = 0.f;
#pragma unroll
  for (int r = 0; r < 16; ++r) { p0[r] = __builtin_amdgcn_exp2f(p0[r]); p1[r] = __builtin_amdgcn_exp2f(p1[r]); s += p0[r] + p1[r]; }
  l += s;
  bf16x8 a0, a1, a2, a3; pack_p1(p0, p1, a0, a1, a2, a3);
#define AT_VFR(x) (bf16x8){vlo[x][0], vlo[x][1], vlo[x][2], vlo[x][3], vhi[x][0], vhi[x][1], vhi[x][2], vhi[x][3]}
  o[0] = __builtin_amdgcn_mfma_f32_32x32x16_bf16(a0, AT_VFR(0), o[0], 0, 0, 0);
  o[1] = __builtin_amdgcn_mfma_f32_32x32x16_bf16(a0, AT_VFR(4), o[1], 0, 0, 0);
  o[0] = __builtin_amdgcn_mfma_f32_32x32x16_bf16(a1, AT_VFR(1), o[0], 0, 0, 0);
  o[1] = __builtin_amdgcn_mfma_f32_32x32x16_bf16(a1, AT_VFR(5), o[1], 0, 0, 0);
  o[0] = __builtin_amdgcn_mfma_f32_32x32x16_bf16(a2, AT_VFR(2), o[0], 0, 0, 0);
  o[1] = __builtin_amdgcn_mfma_f32_32x32x16_bf16(a2, AT_VFR(6), o[1], 0, 0, 0);
  o[0] = __builtin_amdgcn_mfma_f32_32x32x16_bf16(a3, AT_VFR(3), o[0], 0, 0, 0);
  o[1] = __builtin_amdgcn_mfma_f32_32x32x16_bf16(a3, AT_VFR(7), o[1], 0, 0, 0);
#undef AT_VFR
}

__device__ __forceinline__ void row_factors(const Ctx& c, float f, float (&fr)[16]) {
  if (c.hi == 0) c.wsf[c.r32] = f;
  asm volatile("s_waitcnt lgkmcnt(0)" ::: "memory");
#pragma unroll
  for (int r = 0; r < 16; ++r) fr[r] = c.wsf[crow(r, c.hi)];
  asm volatile("s_waitcnt lgkmcnt(0)" ::: "memory");
}
__device__ __forceinline__ void load_z(const Ctx& c, const bf16_t* zbase, u32x4* zv) {
#pragma unroll
  for (int i = 0; i < 4; ++i) zv[i] = *(const u32x4*)(zbase + (size_t)(i * 8 + (c.lane >> 3)) * UP + (c.lane & 7) * 8);
}
__device__ __forceinline__ float silu_mul(float v, unsigned zbits) { const float z = __uint_as_float(zbits); return v * z * __builtin_amdgcn_rcpf(1.f + __builtin_amdgcn_exp2f(-z * LOG2E)); }
__device__ __forceinline__ void epilogue(const Ctx& c, const f32x16* vals, const u32x4* zv, bf16_t* yptr) {
  float* stg = (float*)(c.shm + LDS_OST + c.wid * 8192);
#pragma unroll
  for (int r = 0; r < 16; ++r) { const int row = crow(r, c.hi); stg[row * 64 + c.r32] = vals[0][r]; stg[row * 64 + 32 + c.r32] = vals[1][r]; }
  asm volatile("s_waitcnt lgkmcnt(0)" ::: "memory");
  typedef float f32x4_t __attribute__((ext_vector_type(4)));
#pragma unroll
  for (int i = 0; i < 4; ++i) { const int row = i * 8 + (c.lane >> 3), ch = c.lane & 7;
    const f32x4_t a = *(const f32x4_t*)(stg + row * 64 + ch * 8), b = *(const f32x4_t*)(stg + row * 64 + ch * 8 + 4); const u32x4 z = zv[i];
    u32x4 w; w.x = cvtpk(silu_mul(a.x, z.x << 16), silu_mul(a.y, z.x & 0xffff0000u)); w.y = cvtpk(silu_mul(a.z, z.y << 16), silu_mul(a.w, z.y & 0xffff0000u));
    w.z = cvtpk(silu_mul(b.x, z.z << 16), silu_mul(b.y, z.z & 0xffff0000u)); w.w = cvtpk(silu_mul(b.z, z.w << 16), silu_mul(b.w, z.w & 0xffff0000u));
    *(u32x4*)(yptr + (size_t)row * YP + ch * 8) = w; }
  asm volatile("s_waitcnt lgkmcnt(0)" ::: "memory");
}
__device__ __forceinline__ void load_q(const Ctx& c, const bf16_t* qrow  , bf16x8* q) {
#pragma unroll
  for (int d0 = 0; d0 < 4; ++d0) q[d0] = *(const bf16x8*)(qrow + d0 * 16 + c.hi * 8);
}

__device__ __forceinline__ void moba_unit(const Ctx& c, int b, int h, int qb, bf16x8 (&qr)[4], Ring& rg, UnitP& un, const bf16_t* qnp, const bf16_t* U, const bf16_t* KMHL, const bf16_t* KC, bf16_t* Y) {
  const size_t rowbase = (size_t)b * SEQ; const int row0 = 256 * qb + 32 * c.wid;
  const float slope2 = __builtin_amdgcn_exp2f(-(float)(h + 1)) * LOG2E;
  UnitP u; make_unit(u, 0, b, h, qb, U, KMHL, KC);
  bf16x8 kf[8];
  u32x4 zv[4]; load_z(c, ucol(U, C_ZM + h * 64) + (rowbase + row0) * UP, zv);
  f32x16 o[2]; float m = 0.f, l = 0.f;
  prologue_wait(c, kf, rg);
  unsigned rowmask = 0u;
  {
    const int cnt = step_top(c, u, 0, rg);
    f32x16 pg = f32x16{};
#pragma unroll
    for (int d0 = 0; d0 < 4; ++d0) pg = __builtin_amdgcn_mfma_f32_32x32x16_bf16(kf[2 * d0], qr[d0], pg, 0, 0, 0);
    float own[4], oth[4], sc[8];
#pragma unroll
    for (int i = 0; i < 4; ++i) { own[i] = pg[i] + pg[4 + i]; auto rr = __builtin_amdgcn_permlane32_swap(__float_as_uint(own[i]), __float_as_uint(own[i]), false, false); oth[i] = __uint_as_float(c.hi ? rr[0] : rr[1]); }
#pragma unroll
    for (int i = 0; i < 4; ++i) { sc[i] = c.hi ? oth[i] : own[i]; sc[4 + i] = c.hi ? own[i] : oth[i]; }
#pragma unroll
    for (int n = 0; n < 8; ++n) { int rank = 0;
#pragma unroll
      for (int n2 = 0; n2 < 8; ++n2) if (n2 != n) rank += (int)((n2 < qb) & ((sc[n2] > sc[n]) | ((sc[n2] == sc[n]) & (n2 < n))));
      rowmask |= (unsigned)((n < qb) & (rank < 3)) << n; }
    step_end(c, u, 0, cnt, kf, rg);
  }
  o[0] = f32x16{}; o[1] = f32x16{}; m = 0.f; l = 0.f;
  const float sh = slope2 * (float)(4 * c.hi);
  for (int s = 1; s < u.n; ++s) {
    const int cnt = step_top(c, u, s, rg);
    const int i = s - 1, tile = i < 4 ? 4 * qb + i : i - 4;
    int mode = 0, qx = 0; float rn = 0.f; bool skip = false;
    if (i < 4) { const int lo = 32 * c.wid - 64 * i;
      skip = (lo + 31 < 0); mode = (lo >= 63) ? 0 : 1; qx = lo + c.r32 - 4 * c.hi; }
    else rn = ((rowmask >> (tile >> 2)) & 1u) ? 0.f : NEGINF;
    if (!skip) { f32x16 p0, p1; att_tile<1>(c, rg.vs, kf, next_k(u, s, rg), qr, slope2, slope2 * (float)(64 * tile - 256 * qb) + sh + rn, mode, qx, m, l, o, p0, p1); }
    step_end(c, u, s, cnt, kf, rg, skip);
  }
  prologue_issue(c, un, rg); load_q(c, qnp, qr);
  float fr[16]; row_factors(c, __builtin_amdgcn_rcpf(sum_halves(l)), fr);
#pragma unroll
  for (int r = 0; r < 16; ++r) { o[0][r] *= fr[r]; o[1][r] *= fr[r]; }
  epilogue(c, o, zv, Y + (rowbase + row0) * YP + h * 64);
}

__device__ __forceinline__ float imp_val(const float* IMP, int row, int jj, int qt) {
  float v = ((IMP[(0 * 64 + row) * 33 + jj] + IMP[(1 * 64 + row) * 33 + jj]) + IMP[(2 * 64 + row) * 33 + jj]) + IMP[(3 * 64 + row) * 33 + jj];
  if (jj == 0 || jj == qt || jj == qt - 1) v = 1e4f;
  if (jj > qt) v = -1e9f;
  return v;
}
__device__ __forceinline__ void nsa_unit(const Ctx& c, int b, int g, int qt, bf16x8 (&qr)[4], Ring& rg, UnitP& un, const bf16_t* qnp, const bf16_t* U, const bf16_t* KMHL, const bf16_t* KC, bf16_t* Y) {
  const int j = c.wid >> 1, hf = c.wid & 1, hn = g * 4 + j;
  const size_t rowbase = (size_t)b * SEQ; const int row0 = 64 * qt + 32 * hf;
  const float slope2 = __builtin_amdgcn_exp2f(-(float)(hn + 1)) * LOG2E;
  const bf16_t* glp = ucol(U, C_GL + hn * 3) + (rowbase + row0 + c.r32) * UP;
  float glv0 = bf2f(glp[0]), glv1 = bf2f(glp[1]), glv2 = bf2f(glp[2]);
#define NSA_GATE(k) __builtin_amdgcn_rcpf(1.f + __builtin_amdgcn_exp2f(-((k) == 0 ? glv0 : ((k) == 1 ? glv1 : glv2)) * LOG2E))
  const int qd = 32 * hf + c.r32;
  const int nts = qt + 1, ntw = (qt < 8 ? qt : 8) + 1;
  const bool alls = (qt < 16);
  UnitP u; make_unit(u, 1, b, g, qt, U, KMHL, KC);
  float* IMP = (float*)(c.shm + LDS_IMP);
  unsigned* RM = (unsigned*)(c.shm + LDS_RM);
  float* park = (float*)(c.shm + LDS_OST + c.wid * 8192) + c.lane;
  bf16x8 kf[8];
  prologue_wait(c, kf, rg);
  f32x16 o[2]; o[0] = f32x16{}; o[1] = f32x16{}; float m = 0.f, l = 0.f;
  float G[16], L[16], mA = 0.f;
#pragma unroll
  for (int t = 0; t < 2; ++t) {
    if (t >= u.ncmp) {
#pragma unroll
      for (int i = 0; i < 8; ++i) { G[8 * t + i] = 0.f; L[8 * t + i] = 0.f; }
      continue; }
    const int cnt = step_top(c, u, t, rg);
    f32x16 p0, p1;
    att_tile<16>(c, rg.vs, kf, next_k(u, t, rg), qr, slope2 * 16.f, slope2 * (float)(16 * (64 * t + 4 * c.hi) + 31 - 64 * qt), 1, qd - 16 * (64 * t + 4 * c.hi) - 31 + 64 * qt, m, l, o, p0, p1);
    if (t == 0) mA = m;
#pragma unroll
    for (int cc = 0; cc < 4; ++cc) {
      G[8 * t + cc] = (p0[4 * cc] + p0[4 * cc + 1]) + (p0[4 * cc + 2] + p0[4 * cc + 3]); L[8 * t + cc] = p0[4 * cc + 3];
      G[8 * t + 4 + cc] = (p1[4 * cc] + p1[4 * cc + 1]) + (p1[4 * cc + 2] + p1[4 * cc + 3]); L[8 * t + 4 + cc] = p1[4 * cc + 3]; }
    step_end(c, u, t, cnt, kf, rg, false);
  }
  {
    const float lt = sum_halves(l); const float inv = lt > 0.f ? 1.f / lt : 0.f;
    const float sA = __builtin_amdgcn_exp2f(mA - m) * inv;
    if (!alls) {
    float RL[16];
#pragma unroll
    for (int i = 0; i < 16; ++i) { const float sc = (i < 8) ? sA : inv; G[i] *= sc; L[i] *= sc;
      auto rr = __builtin_amdgcn_permlane32_swap(__float_as_uint(L[i]), __float_as_uint(L[i]), false, false); RL[i] = __uint_as_float(c.hi ? rr[0] : rr[1]); }
#pragma unroll
    for (int i = 0; i < 16; ++i) { const float prev = c.hi ? RL[i] : (i > 0 ? RL[i > 0 ? i - 1 : 0] : 0.f);
      const int jb = 8 * (i >> 2) + 2 * (i & 3) + c.hi;
      IMP[(j * 64 + qd) * 33 + jb] = G[i] + prev; }
    }
    float fr[16]; row_factors(c, NSA_GATE(0) * inv, fr);
#pragma unroll
    for (int r = 0; r < 16; ++r) { o[0][r] *= fr[r]; o[1][r] *= fr[r]; }
  }
  if (!alls) {
  asm volatile("s_waitcnt lgkmcnt(0)\n\ts_barrier" ::: "memory");
  {
    const int tid = c.wid * 64 + c.lane, row = tid >> 3, sub = tid & 7;
    float* S = (float*)(c.shm + LDS_OST);
    float vc[4]; int rank[4];
#pragma unroll
    for (int k = 0; k < 4; ++k) { vc[k] = imp_val(IMP, row, sub * 4 + k, qt); rank[k] = 0; S[row * 33 + sub * 4 + k] = vc[k]; }
    asm volatile("s_waitcnt lgkmcnt(0)\n\ts_barrier" ::: "memory");
    const float* Sr = S + row * 33;
#pragma unroll 8
    for (int jj = 0; jj <= qt; ++jj) { const float v = Sr[jj];
#pragma unroll
      for (int k = 0; k < 4; ++k) rank[k] += (int)((v > vc[k]) | ((v == vc[k]) & (jj < sub * 4 + k))); }
    unsigned bits = 0u;
#pragma unroll
    for (int k = 0; k < 4; ++k) { const int jc = sub * 4 + k; if (rank[k] < 16 && jc <= qt) bits |= (1u << jc); }
    bits |= (unsigned)__builtin_amdgcn_update_dpp(0, (int)bits, 0xB1, 0xF, 0xF, true);
    bits |= (unsigned)__builtin_amdgcn_update_dpp(0, (int)bits, 0x4E, 0xF, 0xF, true);
    bits |= (unsigned)__builtin_amdgcn_update_dpp(0, (int)bits, 0x141, 0xF, 0xF, true);
    if (sub == 0) RM[row] = bits;
  }
  asm volatile("s_waitcnt lgkmcnt(0)\n\ts_barrier" ::: "memory");
  }
  const unsigned rowmask = alls ? ((2u << qt) - 1u) : RM[qd];
  unsigned rem = 0u;
  if (alls) { if (qt >= 5) rem = ((1u << (qt - 3)) - 1u) & ~1u; }
  else if (qt >= 5) {
    unsigned um = RM[c.lane];
    um |= (unsigned)__builtin_amdgcn_update_dpp(0, (int)um, 0xB1, 0xF, 0xF, true); um |= (unsigned)__builtin_amdgcn_update_dpp(0, (int)um, 0x4E, 0xF, 0xF, true);
    um |= (unsigned)__builtin_amdgcn_update_dpp(0, (int)um, 0x141, 0xF, 0xF, true); um |= (unsigned)__builtin_amdgcn_update_dpp(0, (int)um, 0x140, 0xF, 0xF, true);
    { auto rr = __builtin_amdgcn_permlane16_swap(um, um, false, false); um = rr[0] | rr[1]; }
    { auto rr = __builtin_amdgcn_permlane32_swap(um, um, false, false); um = rr[0] | rr[1]; }
    rem = (unsigned)__builtin_amdgcn_readfirstlane((int)um) & (((1u << (qt - 3)) - 1u) & ~1u);
    u.remk = rem; u.remv = rem; u.remc = rem; u.nts = u.npre + __builtin_popcount(rem); u.n = u.ncmp + u.nts + ntw;
  }
  u32x4 zv[4]; load_z(c, ucol(U, C_ZN + hn * 64) + (rowbase + row0) * UP, zv);
#pragma unroll
  for (int r = 0; r < 16; ++r) { park[(2 * r) * 64] = o[0][r]; park[(2 * r + 1) * 64] = o[1][r]; }
  int* TAB = (int*)(c.shm + LDS_TAB);
  if (c.wid == 0) {
    const int ksoff = (int)((const char*)u.k1 - (const char*)U), kwoff = (int)((const char*)u.k2 - (const char*)U);
    const int t = c.lane; int e = -1, tile = 0, kind = 0;
    if (t < 32) { if ((rem >> t) & 1u) { e = u.ncmp + u.npre + __builtin_popcount(rem & ((1u << t) - 1u)); tile = t; } }
    else if (t < 40) { const int jp = t - 32; if (jp < u.npre) { e = u.ncmp + jp; tile = (int)((u.pre >> (5 * jp)) & 31u); } }
    else if (t < 49) { const int jw = t - 40; if (jw < ntw) { e = u.ncmp + u.nts + jw; tile = qt - jw; kind = 1; } }
    if (e >= 0) {
      const int js = e - u.ncmp;
      const int ko = (kind ? kwoff : ksoff) + tile * 8192;
      const int mode = kind ? ((tile == qt) ? 1 : ((qt - tile == 8) ? 2 : 0)) : ((js == 0) ? 1 : 0);
      const int maskf = (!kind && js != 0) ? 1 : 0, fold = (js == u.nts - 1 || e == u.n - 1) ? 1 : 0;
      TAB[e * 4] = ko; TAB[e * 4 + 1] = ko + (int)(DV_N * 2); TAB[e * 4 + 2] = tile | (kind << 5) | (maskf << 6) | (mode << 7) | (fold << 9);
    }
  }
  asm volatile("s_waitcnt lgkmcnt(0)\n\ts_barrier" ::: "memory");
  o[0] = f32x16{}; o[1] = f32x16{}; m = 0.f; l = 0.f;
  const float sh = slope2 * (float)(4 * c.hi); const int qx = qd - 4 * c.hi;
  int nko = TAB[(u.ncmp + KA) * 4], nvo = TAB[(u.ncmp + VA) * 4 + 1], ninfo = TAB[u.ncmp * 4 + 2];
  for (int s = u.ncmp; s < u.n; ++s) {
    int cnt = 0;
    const int ko = nko, vo = nvo; const int info = __builtin_amdgcn_readfirstlane(ninfo);
    nko = TAB[(s + 1 + KA) * 4]; nvo = TAB[(s + 1 + VA) * 4 + 1]; ninfo = TAB[(s + 1) * 4 + 2];
    { const int ek = s + KA, ev = s + VA;
      if (ek < u.n) { dma_k_off(c, U, ko, rg.ks == 0 ? NKS - 1 : rg.ks - 1); ++cnt; }
      if (ev < u.n) { dma_v_off(c, U, vo, rg.vs == 0 ? NVS - 1 : rg.vs - 1); ++cnt; } }
    const int tile = info & 31, mode = (info >> 7) & 3; const bool win = (info >> 5) & 1, fold = (info >> 9) & 1;
    float t0 = slope2 * (float)(64 * (tile - qt)) + sh;
    if ((info >> 6) & 1) t0 += ((rowmask >> tile) & 1u) ? 0.f : NEGINF;
    f32x16 p0, p1; att_tile<1>(c, rg.vs, kf, next_k(u, s, rg), qr, slope2, t0, mode, qx, m, l, o, p0, p1);
    if (fold) {
      float fr[16]; row_factors(c, (win ? NSA_GATE(2) : NSA_GATE(1)) * __builtin_amdgcn_rcpf(sum_halves(l)), fr);
#pragma unroll
      for (int r = 0; r < 16; ++r) { park[(2 * r) * 64] += o[0][r] * fr[r]; park[(2 * r + 1) * 64] += o[1][r] * fr[r]; }
      o[0] = f32x16{}; o[1] = f32x16{}; m = 0.f; l = 0.f;
    }
    step_end(c, u, s, cnt, kf, rg, false);
  }
  prologue_issue(c, un, rg); load_q(c, qnp, qr);
#pragma unroll
  for (int r = 0; r < 16; ++r) { o[0][r] = park[(2 * r) * 64]; o[1][r] = park[(2 * r + 1) * 64]; }
  asm volatile("s_waitcnt lgkmcnt(0)" ::: "memory");
  epilogue(c, o, zv, Y + (rowbase + row0) * YP + 512 + hn * 64);
#undef NSA_GATE
}

__device__ __forceinline__ void unit_of(int v, int uidx, int& type, int& b, int& hg, int& qi) {
  const int r = uidx >> 1, j = v & 7, qb = (j + r) & 7;
  b = v >> 3;
  if ((uidx & 1) == 0) { type = 0; hg = r; qi = qb; }
  else { type = 1; hg = r & 1; qi = 28 - 4 * qb + (r >> 1); }
}
__device__ __forceinline__ void attn_phase(char* shm, const bf16_t* U, const bf16_t* KMHL, const bf16_t* KC, bf16_t* Y, int vcu, const int wid) {
  const int G = gridDim.x;
  for (int vb = blockIdx.x; vb < 256; vb += G) {
    const int v = (vcu >= 0) ? vcu : vb;
    bf16x8 qr[4]; Ring rg;
    for (int uidx = 0; uidx < 16; ++uidx) {
      int lane; asm volatile("v_mbcnt_lo_u32_b32 %0, -1, 0\n\tv_mbcnt_hi_u32_b32 %0, -1, %0" : "=v"(lane));
      Ctx c; c.shm = shm; c.lds0 = (unsigned)(uintptr_t)shm; c.lane = lane; c.r32 = lane & 31; c.hi = lane >> 5; c.wid = wid;
#pragma unroll
      for (int d0 = 0; d0 < 4; ++d0) c.ka.a[d0] = (lds_cptr)shm + LDS_K + c.r32 * 128 + (((2 * d0 + c.hi) ^ ((c.r32 >> 1) & 7)) << 4);
      c.vb0 = 0;
      { const int krow = 8 * wid + (lane >> 3), jp = lane & 7;
        c.koff = (krow * UP + (((lane & 7) ^ ((krow >> 1) & 7)) << 3)) * 2;
        c.voff = (krow * UP + ((((jp >> 1) ^ (((krow >> 1) & 1) << 1)) << 1) | (jp & 1)) * 8) * 2; }
      c.wsf = (float*)(shm + LDS_WS) + wid * 64;
      int type, b, hg, qi; unit_of(v, uidx, type, b, hg, qi);
      if (uidx == 0) { UnitP u0; make_unit(u0, type, b, hg, qi, U, KMHL, KC); prologue_issue(c, u0, rg); load_q(c, q_row(c, type, b, hg, qi, U), qr); }
      int tn, bn, hgn, qin; unit_of(v, uidx < 15 ? uidx + 1 : 15, tn, bn, hgn, qin);
      UnitP un; make_unit(un, tn, bn, hgn, qin, U, KMHL, KC);
      const bf16_t* qnp = q_row(c, tn, bn, hgn, qin, U);
      if (type == 1) nsa_unit(c, b, hg, qi, qr, rg, un, qnp, U, KMHL, KC, Y);
      else moba_unit(c, b, hg, qi, qr, rg, un, qnp, U, KMHL, KC, Y);
    }
    asm volatile("s_waitcnt vmcnt(0)\n\ts_barrier" ::: "memory");
  }
}
#undef AT_WAIT_BAR
#undef AT_SBAR
}
constexpr int NWAVES = 8;
constexpr int BATCH = 32, SEQ = 2048, D = 1024, DEPTH = 2, MROWS = BATCH * SEQ;
constexpr int D_IN = 3864, NU = 4096;
constexpr int N_G1 = 3840;
constexpr float RMS_EPS = 1e-6f;
constexpr float QSCALE = 0.125f * 1.4426950408889634f;

typedef unsigned short bf16;
typedef unsigned v4u __attribute__((ext_vector_type(4)));
typedef float f32x4 __attribute__((ext_vector_type(4)));
typedef short bf16x8 __attribute__((ext_vector_type(8)));
#define LAS __attribute__((address_space(3)))

constexpr size_t MiB = 1u << 20;
constexpr size_t WS_CTL = 0, CTL_ZERO_BYTES = 65536;
constexpr int CW_XR = 1024;
constexpr int CW_BAR = 4096;
constexpr int CW_GRP = 8192;
constexpr size_t WS_WIN = 2 * MiB;
constexpr size_t WS_WOUT = 18 * MiB;
constexpr size_t WS_WC1 = 22 * MiB;
constexpr size_t WS_WC2 = 23 * MiB;
constexpr size_t WS_PEC = 23 * MiB + 512 * 1024;
constexpr size_t WS_MOD = 24 * MiB;
constexpr size_t WS_KMHL = 25 * MiB;
constexpr size_t WS_KC = 26 * MiB, WS_VC = 27 * MiB;
constexpr size_t WS_KMACC = 28 * MiB;
constexpr size_t WS_H = 32 * MiB;
constexpr size_t WS_Y = 160 * MiB;
constexpr size_t WS_O = 288 * MiB;
constexpr size_t WS_U = 416 * MiB;
constexpr size_t WS_END = 928 * MiB;
constexpr int CW_WQ = 64;

constexpr int LDS_BYTES = 163840;
constexpr int LDS_MISC = LDS_BYTES - 256;
static_assert(att::LDS_END <= LDS_MISC, "attention LDS map");

__device__ __forceinline__ unsigned pk2(float lo, float hi) { typedef float f2_t_ __attribute__((ext_vector_type(2))); typedef __bf16 b2_t_ __attribute__((ext_vector_type(2)));
    const f2_t_ v = {lo, hi}; return __builtin_bit_cast(unsigned, __builtin_convertvector(v, b2_t_)); }
__device__ __forceinline__ unsigned f2bf(float f) { return pk2(f, 0.f) & 0xffffu; }
__device__ __forceinline__ float bf2f(unsigned short v) { return __uint_as_float((unsigned)v << 16); }
__device__ __forceinline__ float wave_sum(float v) {
    v += __builtin_bit_cast(float, __builtin_amdgcn_update_dpp(0, __builtin_bit_cast(int, v), 0xB1, 0xF, 0xF, true));
    v += __builtin_bit_cast(float, __builtin_amdgcn_update_dpp(0, __builtin_bit_cast(int, v), 0x4E, 0xF, 0xF, true));
    v += __builtin_bit_cast(float, __builtin_amdgcn_update_dpp(0, __builtin_bit_cast(int, v), 0x141, 0xF, 0xF, true));
    v += __builtin_bit_cast(float, __builtin_amdgcn_update_dpp(0, __builtin_bit_cast(int, v), 0x140, 0xF, 0xF, true));
    { auto rr = __builtin_amdgcn_permlane16_swap(__float_as_uint(v), __float_as_uint(v), false, false); v = __uint_as_float(rr[0]) + __uint_as_float(rr[1]); }
    { auto rr = __builtin_amdgcn_permlane32_swap(__float_as_uint(v), __float_as_uint(v), false, false); v = __uint_as_float(rr[0]) + __uint_as_float(rr[1]); }
    return v;
}

#define GAS __attribute__((address_space(1)))
typedef GAS unsigned gu32;
#define RLX_AGENT __ATOMIC_RELAXED, __HIP_MEMORY_SCOPE_AGENT
#define XB_TMO      128
#define XB_XCNT(j)  (256  + 64 * (j))
#define XB_XSUB(j)  (1280 + 64 * (j))
#define XB_XGEN(j)  (2304 + 64 * (j))
#define XB_TOP      3328
#define XB_TOPGEN   3392
#define XCD_BAR_WORDS 3456
#define XB_SPIN_CAP (1u << 18)

__device__ __forceinline__ unsigned xb_ld(unsigned* p)              { return __hip_atomic_load(p, __ATOMIC_RELAXED, __HIP_MEMORY_SCOPE_AGENT); }
__device__ __forceinline__ unsigned xb_add(unsigned* p, unsigned v) { return __hip_atomic_fetch_add(p, v, __ATOMIC_RELAXED, __HIP_MEMORY_SCOPE_AGENT); }
__device__ __forceinline__ unsigned xb_xcc_id() { return (unsigned)__builtin_amdgcn_s_getreg((3 << 11) | 20) & 0xFu; }
#define XB_SPIN(cond, bar) do { unsigned _sp = 0; while (cond) { __builtin_amdgcn_s_sleep(1); \
    if ((++_sp & 255u) == 0u) { if (xb_ld(&(bar)[XB_TMO])) break; if (_sp > XB_SPIN_CAP) { atomicAdd(&(bar)[XB_TMO], 1u); break; } } } } while (0)

struct XcdBarrier {
    unsigned* bar; unsigned x;
    volatile LAS unsigned* st;
};

__device__ __forceinline__ XcdBarrier xcd_barrier_post(unsigned* bar, volatile LAS unsigned* st) {
    XcdBarrier b; b.bar = bar; b.x = xb_xcc_id(); b.st = st;
    if (threadIdx.x == 0) (void)xb_add(&bar[XB_XCNT(b.x)], 1u);
    return b;
}
__device__ __forceinline__ void xcd_barrier_complete(unsigned* bar, unsigned x, unsigned& nloc, unsigned& nx) {
    const unsigned G = gridDim.x * gridDim.y * gridDim.z;
    unsigned sum, cnt, mine, sp = 0u;
    for (;;) {
        sum = 0u; cnt = 0u; mine = 0u;
#pragma unroll
        for (unsigned j = 0; j < 16; ++j) { const unsigned c = xb_ld(&bar[XB_XCNT(j)]); sum += c; cnt += (c > 0u) ? 1u : 0u; mine = (j == x) ? c : mine; }
        if (sum == G) break;
        __builtin_amdgcn_s_sleep(1);
        if ((++sp & 255u) == 0u) { if (xb_ld(&bar[XB_TMO])) break; if (sp > XB_SPIN_CAP) { atomicAdd(&bar[XB_TMO], 1u); break; } }
    }
    nloc = mine > 0u ? mine : 1u; nx = cnt > 0u ? cnt : 1u;
}

__device__ __forceinline__ void xcd_barrier(const XcdBarrier& b, const bool t0  ) {
    asm volatile("s_waitcnt vmcnt(0)" ::: "memory");
    __syncthreads();
    if (t0) {
        unsigned* bar = b.bar;
        __builtin_amdgcn_s_waitcnt(0);
        unsigned nloc = b.st[0], nx = b.st[1];
        if (nloc == 0u) { xcd_barrier_complete(bar, b.x, nloc, nx); b.st[0] = nloc; b.st[1] = nx; }
        const unsigned old = xb_add(&bar[XB_XSUB(b.x)], 1u);
        const unsigned gen = old / nloc;
        if (old + 1u == (gen + 1u) * nloc) {
            __builtin_amdgcn_fence(__ATOMIC_RELEASE, "agent");
            asm volatile("s_waitcnt vmcnt(0)" ::: "memory");
            const unsigned og = xb_add(&bar[XB_TOP], 1u);
            const unsigned tg = og / nx;
            if (og + 1u == (tg + 1u) * nx) xb_add(&bar[XB_TOPGEN], 1u);
            else XB_SPIN(xb_ld(&bar[XB_TOPGEN]) == tg, bar);
            __builtin_amdgcn_fence(__ATOMIC_ACQUIRE, "agent");
            xb_add(&bar[XB_XGEN(b.x)], 1u);
            asm volatile("s_waitcnt vmcnt(0)" ::: "memory");
        } else {
            XB_SPIN(xb_ld(&bar[XB_XGEN(b.x)]) == gen, bar);
            __builtin_amdgcn_fence(__ATOMIC_ACQUIRE, "agent");
            asm volatile("s_waitcnt vmcnt(0)" ::: "memory");
        }
    }
    __syncthreads();
}

__device__ __forceinline__ void group_barrier(unsigned* bar, unsigned* cnt, unsigned target, bool same_xcd, const bool t0) {
    asm volatile("s_waitcnt vmcnt(0)" ::: "memory");
    __syncthreads();
    if (t0) {
        __builtin_amdgcn_s_waitcnt(0);
        if (!same_xcd) { __builtin_amdgcn_fence(__ATOMIC_RELEASE, "agent"); asm volatile("s_waitcnt vmcnt(0)" ::: "memory"); }
        (void)xb_add(cnt, 1u);
        XB_SPIN(xb_ld(cnt) < target, bar);
        __builtin_amdgcn_fence(__ATOMIC_ACQUIRE, "agent");
        asm volatile("s_waitcnt vmcnt(0)" ::: "memory");
    }
    __syncthreads();
}

__device__ __forceinline__ int lane_id() { int l; asm volatile("v_mbcnt_lo_u32_b32 %0, -1, 0\n\tv_mbcnt_hi_u32_b32 %0, -1, %0" : "=v"(l)); return l; }

struct Args { const float* in[14]; float* out; unsigned char* ws; int cg_seam; int pad_; };

__device__ __forceinline__ void tr_load(const float* W, int N, int item, int lane, float (&tv)[32]) {
    const int nblk = (N + 31) / 32, kb = item / nblk, nb = item % nblk, k0 = 64 * kb, n0 = 32 * nb;
    const int nl = n0 + (lane & 31);
#pragma unroll
    for (int i = 0; i < 32; ++i) { const int kk = 2 * i + (lane >> 5); tv[i] = (nl < N) ? W[(size_t)(k0 + kk) * N + nl] : 0.f; }
}
__device__ __forceinline__ void tr_store(const int MAP, int K, int N, bf16* WT, LAS float* scr, int item, int lane, const float (&tv)[32]) {
    const int nblk = (N + 31) / 32, kb = item / nblk, nb = item % nblk, k0 = 64 * kb, n0 = 32 * nb;
#pragma unroll
    for (int i = 0; i < 32; ++i) { const int kk = 2 * i + (lane >> 5); scr[kk * 33 + (lane & 31)] = tv[i]; }
    asm volatile("s_waitcnt lgkmcnt(0)" ::: "memory");
    const int c = lane & 7;
#pragma unroll
    for (int j = 0; j < 4; ++j) { const int n = (lane >> 3) + 8 * j; const int ns = n0 + n; const LAS float* s = scr + (8 * c) * 33 + n;
        int nd = ns; float sc = 1.f;
        if (MAP == 1) { if (ns >= 3328 && ns < 3352) nd = ns + 512; else if (ns >= 3352) nd = ns - 24; if (ns < 512 || (ns >= 2048 && ns < 2560)) sc = QSCALE; }
        v4u o; o.x = pk2(s[0 * 33] * sc, s[1 * 33] * sc); o.y = pk2(s[2 * 33] * sc, s[3 * 33] * sc); o.z = pk2(s[4 * 33] * sc, s[5 * 33] * sc); o.w = pk2(s[6 * 33] * sc, s[7 * 33] * sc);
        if (ns < N) *(v4u*)(WT + (size_t)nd * K + k0 + 8 * c) = o; }
    asm volatile("s_waitcnt lgkmcnt(0)" ::: "memory");
}

__device__ __forceinline__ void weight_copies(const Args& a, LAS float* scr, int first, int stride, int lane) {
    unsigned char* ws = a.ws;
    constexpr int I_IN = (D / 64) * ((D_IN + 31) / 32);
    constexpr int I_OUT = (D / 64) * (D / 32);
    constexpr int I_C1 = (2048 / 64) * (64 / 32);
    constexpr int I_C2 = 1 * 2;
    constexpr int I_PAD = 232;
    constexpr int PER_L = I_IN + I_OUT + 2 * I_C1 + 2 * I_C2 + I_PAD;
    for (int it = first; it < PER_L; it += stride) {
        int r = it;
        bf16* win_t = (bf16*)(ws + WS_WIN);
        const float* W; bf16* WT; int K, N, map = 0, item; size_t ws1, wt1;
        if (r < I_IN) { W = a.in[6]; ws1 = (size_t)D * D_IN; K = D; N = D_IN; WT = win_t; wt1 = (size_t)NU * D; map = 1; item = r; }
        else if ((r -= I_IN) < I_OUT) { W = a.in[7]; ws1 = (size_t)D * D; K = D; N = D; WT = (bf16*)(ws + WS_WOUT); wt1 = (size_t)D * D; item = r; }
        else if ((r -= I_OUT) < 2 * I_C1) { const int kv = r >= I_C1; W = a.in[kv ? 12 : 10]; ws1 = (size_t)2048 * 64; K = 2048; N = 64; WT = (bf16*)(ws + WS_WC1) + (size_t)kv * 64 * 2048; wt1 = (size_t)2 * 64 * 2048; item = r - kv * I_C1; }
        else if ((r -= 2 * I_C1) < 2 * I_C2) { const int kv = r >= I_C2; W = a.in[kv ? 13 : 11]; ws1 = (size_t)64 * 64; K = 64; N = 64; WT = (bf16*)(ws + WS_WC2) + (size_t)kv * 64 * 64; wt1 = (size_t)2 * 64 * 64; item = r - kv * I_C2; }
        else { r -= 2 * I_C2; W = nullptr; WT = nullptr; K = 0; N = 0; item = 0; ws1 = 0; wt1 = 0; }
        if (W) { float t0[32], t1[32];
            tr_load(W, N, item, lane, t0); tr_load(W + ws1, N, item, lane, t1);
            tr_store(map, K, N, WT, scr, item, lane, t0); tr_store(map, K, N, WT + wt1, scr + 64 * 33, item, lane, t1);
            continue; }
        { v4u z = {0u, 0u, 0u, 0u};
#pragma unroll
          for (int l = 0; l < 2; ++l) { v4u* p = (v4u*)(win_t + (size_t)l * NU * D + (size_t)(D_IN + r) * D); p[lane] = z; p[lane + 64] = z; } }
    }
}

__device__ __forceinline__ void p0_prologue(const Args& a, LAS unsigned char* lds, int bid, int G, int tid, int wave, int lane) {
    unsigned char* ws = a.ws;
    float wv[8][8];
    auto ada_load = [&](int item) {
        const int l = item / 96, n0 = (item % 96) * 32;
        const int r32 = lane & 31, hi = lane >> 5;
        const float* W = a.in[2] + (size_t)l * D * 3072 + n0 + r32;
        unsigned wp = (unsigned)(wave * 128 + 8 * hi) * 3072u; asm volatile("" : "+v"(wp));
#pragma unroll
        for (int st = 0; st < 8; ++st) {
#pragma unroll
            for (int j = 0; j < 8; ++j) { wv[st][j] = W[wp]; wp += 3072u; asm volatile("" : "+v"(wp)); }
            wp += 8u * 3072u; asm volatile("" : "+v"(wp)); } };
    if (bid < 2 * 96) ada_load(bid);
    float cpre0 = 0.f, cpre1 = 0.f, bpre = 0.f;
    if (bid < 2 * 96) { const float* cp = a.in[1] + (size_t)(lane & 31) * D + wave * 128 + (lane >> 5) * 64; cpre0 = cp[0]; cpre1 = cp[32];
        bpre = a.in[3][(size_t)(bid / 96) * 3072 + (bid % 96) * 32 + (lane & 31)]; }
    { const v4u z = {0u, 0u, 0u, 0u}; for (int i = bid * 512 + tid; i < 65536; i += G * 512) ((v4u*)(ws + WS_KMACC))[i] = z; }
    weight_copies(a, (LAS float*)(lds + wave * 20480), bid * NWAVES + wave, G * NWAVES, lane);
    asm volatile("" :: "v"(cpre0), "v"(cpre1), "v"(bpre));
    if (bid >= G - 16) { const int id = bid - (G - 16), lkv = id >> 2, nq = id & 3, l = lkv >> 1, kv = lkv & 1;
        const float* pe = a.in[kv ? 9 : 8] + (size_t)l * 2048; const float* w1 = a.in[kv ? 12 : 10] + (size_t)l * 2048 * 64;
        const int n4 = tid & 3, sl = tid >> 2;
        f32x4 wr[16], pv[4];
#pragma unroll
        for (int i = 0; i < 16; ++i) wr[i] = ((const f32x4*)(w1 + (size_t)(sl * 16 + i) * 64))[nq * 4 + n4];
#pragma unroll
        for (int i = 0; i < 4; ++i) pv[i] = ((const f32x4*)(pe + sl * 16))[i];
        f32x4 s = {0.f, 0.f, 0.f, 0.f};
#pragma unroll
        for (int i = 0; i < 16; ++i) s += wr[i] * pv[i >> 2][i & 3];
        __syncthreads();
        LAS f32x4* red = (LAS f32x4*)lds; red[sl * 4 + n4] = s;
        __syncthreads();
        if (tid < 4) { f32x4 t = {0.f, 0.f, 0.f, 0.f};
#pragma unroll 16
            for (int w = 0; w < 128; ++w) t += red[w * 4 + tid];
            ((f32x4*)(ws + WS_PEC))[(l * 2 + kv) * 16 + nq * 4 + tid] = t; }
    }
    __syncthreads();
    for (int item = bid; item < 2 * 96; item += G) {
        const int l = item / 96, n0 = (item % 96) * 32;
        const int r32 = lane & 31, hi = lane >> 5;
        if (item != bid) ada_load(item);
        const float* cb = a.in[1] + (size_t)r32 * D + wave * 128 + 8 * hi;
        f32x4 ca[8][2];
#pragma unroll
        for (int st = 0; st < 8; ++st) { ca[st][0] = *(const f32x4*)(cb + st * 16); ca[st][1] = *(const f32x4*)(cb + st * 16 + 4); }
        att::f32x16 acc = att::f32x16{};
#pragma unroll
        for (int st = 0; st < 8; ++st) {
            unsigned ah[4], al[4], bh[4], bl[4];
#pragma unroll
            for (int q = 0; q < 4; ++q) {
                float x0 = ca[st][q >> 1][(q & 1) * 2], x1 = ca[st][q >> 1][(q & 1) * 2 + 1];
                x0 = x0 / (1.f + __expf(-x0)); x1 = x1 / (1.f + __expf(-x1));
                const unsigned h0 = f2bf(x0), h1 = f2bf(x1);
                ah[q] = h0 | (h1 << 16); al[q] = pk2(x0 - __uint_as_float(h0 << 16), x1 - __uint_as_float(h1 << 16));
                const float w0 = wv[st][2 * q], w1 = wv[st][2 * q + 1]; const unsigned g0 = f2bf(w0), g1 = f2bf(w1);
                bh[q] = g0 | (g1 << 16); bl[q] = pk2(w0 - __uint_as_float(g0 << 16), w1 - __uint_as_float(g1 << 16)); }
            const v4u ahv = {ah[0], ah[1], ah[2], ah[3]}, alv = {al[0], al[1], al[2], al[3]}, bhv = {bh[0], bh[1], bh[2], bh[3]}, blv = {bl[0], bl[1], bl[2], bl[3]};
            acc = __builtin_amdgcn_mfma_f32_32x32x16_bf16(__builtin_bit_cast(bf16x8, ahv), __builtin_bit_cast(bf16x8, bhv), acc, 0, 0, 0);
            acc = __builtin_amdgcn_mfma_f32_32x32x16_bf16(__builtin_bit_cast(bf16x8, alv), __builtin_bit_cast(bf16x8, bhv), acc, 0, 0, 0);
            acc = __builtin_amdgcn_mfma_f32_32x32x16_bf16(__builtin_bit_cast(bf16x8, ahv), __builtin_bit_cast(bf16x8, blv), acc, 0, 0, 0);
        }
        LAS float* part = (LAS float*)lds + wave * 1024;
#pragma unroll
        for (int r = 0; r < 16; ++r) part[((r & 3) + 8 * (r >> 2) + 4 * hi) * 32 + r32] = acc[r];
        __syncthreads();
        for (int o = tid; o < 1024; o += 512) { const int b = o >> 5, cc = o & 31; float s = 0.f;
#pragma unroll
            for (int w = 0; w < 8; ++w) s += ((LAS float*)lds)[w * 1024 + o];
            ((float*)(ws + WS_MOD))[((size_t)l * 32 + b) * 3072 + n0 + cc] = s + a.in[3][(size_t)l * 3072 + n0 + cc]; }
        __syncthreads();
    }
}

__device__ __forceinline__ void pack_row(const f32x4 (&v)[4], unsigned long long (&w)[4]) {
#pragma unroll
    for (int j = 0; j < 4; ++j) w[j] = (unsigned long long)pk2(v[j].x, v[j].y) | ((unsigned long long)pk2(v[j].z, v[j].w) << 32);
}
__device__ __forceinline__ void store_row_w(bf16* orow, int lane, const unsigned long long (&w)[4]) {
    unsigned long long* o8 = (unsigned long long*)orow + lane;
#pragma unroll
    for (int j = 0; j < 4; ++j) o8[64 * j] = w[j];
}
__device__ __forceinline__ void store_bf16_row(bf16* orow, int lane, const f32x4 (&v)[4]) { unsigned long long w[4]; pack_row(v, w); store_row_w(orow, lane, w); }
constexpr int GL_PITCH = 2064, GL_PART = 2 * 16 * GL_PITCH;
struct GateW { bf16x8 w[2][4]; };
__device__ __forceinline__ void gl_load_w(GateW& g, const bf16* win_t, int wave, int lane) {
    const int fr = lane & 15, fq = lane >> 4;
#pragma unroll
    for (int nt = 0; nt < 2; ++nt)
#pragma unroll
        for (int kk = 0; kk < 4; ++kk) g.w[nt][kk] = *(const bf16x8*)(win_t + (size_t)(N_G1 + 16 * nt + fr) * D + 128 * wave + 32 * kk + 8 * fq);
}
__device__ __forceinline__ void gl_put_row_w(LAS unsigned char* lds, int sb, int slot, int lane, const unsigned long long (&w)[4]) {
    LAS unsigned long long* p = (LAS unsigned long long*)(lds + (sb * 16 + slot) * GL_PITCH) + lane;
#pragma unroll
    for (int j = 0; j < 4; ++j) p[64 * j] = w[j];
}
__device__ __forceinline__ void gl_partial(LAS unsigned char* lds, int sb, int wave, int lane, const GateW& g) {
    const int fr = lane & 15, fq = lane >> 4;
    f32x4 acc[2] = {(f32x4){0.f, 0.f, 0.f, 0.f}, (f32x4){0.f, 0.f, 0.f, 0.f}};
#pragma unroll
    for (int kk = 0; kk < 4; ++kk) { const bf16x8 af = *(const LAS bf16x8*)(lds + (sb * 16 + fr) * GL_PITCH + (128 * wave + 32 * kk + 8 * fq) * 2);
#pragma unroll
        for (int nt = 0; nt < 2; ++nt) acc[nt] = __builtin_amdgcn_mfma_f32_16x16x32_bf16(af, g.w[nt][kk], acc[nt], 0, 0, 0); }
    LAS float* part = (LAS float*)(lds + GL_PART + (sb * 8 + wave) * 2048);
#pragma unroll
    for (int nt = 0; nt < 2; ++nt)
#pragma unroll
        for (int r = 0; r < 4; ++r) part[(4 * fq + r) * 32 + 16 * nt + fr] = acc[nt][r];
}
__device__ __forceinline__ void gl_reduce(LAS unsigned char* lds, int s, int tid, bf16* glt) {
    const int slot = tid >> 5, col = tid & 31; float t = 0.f;
    const LAS float* part = (const LAS float*)(lds + GL_PART + ((s & 1) * 8) * 2048) + slot * 32 + col;
#pragma unroll
    for (int w = 0; w < 8; ++w) t += part[w * 512];
    glt[(size_t)(32 * (slot >> 1) + 2 * s + (slot & 1)) * 64 + col] = (bf16)f2bf(t);
}
__device__ __forceinline__ void prenorm0_phase(const Args& a, LAS unsigned char* lds, int bid, int G, int tid, int wave, int lane) {
    const float* mod = (const float*)(a.ws + WS_MOD); bf16* H = (bf16*)(a.ws + WS_H);
    GateW gwt; gl_load_w(gwt, (const bf16*)(a.ws + WS_WIN), wave, lane);
    for (int blk = bid; blk < MROWS / 256; blk += G) {
        const int m0 = blk * 256 + wave * 32, b = m0 / SEQ;
        bf16* glt = (bf16*)att::ucol((const bf16*)(a.ws + WS_U), att::C_GL) + (size_t)blk * 256 * 64;
        f32x4 gs[4], sh[4];
#pragma unroll
        for (int j = 0; j < 4; ++j) { const int k4 = lane + 64 * j; const f32x4 g = ((const f32x4*)a.in[4])[k4]; const f32x4 sc = ((const f32x4*)(mod + (size_t)b * 3072 + 1024))[k4];
            gs[j] = g * (sc + 1.f); sh[j] = ((const f32x4*)(mod + (size_t)b * 3072))[k4]; }
        f32x4 nx[4];
        { const f32x4* xr = (const f32x4*)(a.in[0] + (size_t)m0 * D) + lane;
#pragma unroll
          for (int j = 0; j < 4; ++j) nx[j] = xr[64 * j]; }
        for (int s = 0; s < 16; ++s) {
#pragma unroll
            for (int e = 0; e < 2; ++e) {
                const int m = m0 + 2 * s + e;
                f32x4 v[4]; float ss = 0.f;
#pragma unroll
                for (int j = 0; j < 4; ++j) v[j] = nx[j];
                if (2 * s + e + 1 < 32) { const f32x4* xr = (const f32x4*)(a.in[0] + (size_t)(m + 1) * D) + lane;
#pragma unroll
                    for (int j = 0; j < 4; ++j) nx[j] = xr[64 * j]; }
#pragma unroll
                for (int j = 0; j < 4; ++j) ss += (v[j].x * v[j].x + v[j].y * v[j].y) + (v[j].z * v[j].z + v[j].w * v[j].w);
                const float rstd = 1.f / sqrtf(wave_sum(ss) * (1.f / D) + RMS_EPS);
#pragma unroll
                for (int j = 0; j < 4; ++j) v[j] = v[j] * rstd * gs[j] + sh[j];
                { unsigned long long w[4]; pack_row(v, w); store_row_w(H + (size_t)m * D, lane, w); gl_put_row_w(lds, s & 1, 2 * wave + e, lane, w); }
            }
            __syncthreads();
            gl_partial(lds, s & 1, wave, lane, gwt);
            if (s > 0) gl_reduce(lds, s - 1, tid, glt);
        }
        __syncthreads();
        gl_reduce(lds, 15, tid, glt);
        __syncthreads();
    }
}
template <int L>
__device__ __forceinline__ void pn_load(const Args& a, const bf16* O, int m, int lane, unsigned long long (&no)[4], f32x4 (&nx)[4], unsigned long long (&nb)[4]) {
    const unsigned long long* orow = (const unsigned long long*)(O + (size_t)m * D) + lane;
#pragma unroll
    for (int j = 0; j < 4; ++j) no[j] = orow[64 * j];
    if constexpr (L == 0) { const f32x4* xr = (const f32x4*)(a.in[0] + (size_t)m * D) + lane;
#pragma unroll
        for (int j = 0; j < 4; ++j) nx[j] = xr[64 * j]; }
    else { const unsigned long long* xb = (const unsigned long long*)((const char*)a.out + (size_t)m * (D * 4)) + lane;
#pragma unroll
        for (int j = 0; j < 4; ++j) nb[j] = xb[64 * j]; }
}
__device__ __forceinline__ f32x4 unpack4(unsigned long long w) { f32x4 r; r.x = bf2f((unsigned short)w); r.y = bf2f((unsigned short)(w >> 16)); r.z = bf2f((unsigned short)(w >> 32)); r.w = bf2f((unsigned short)(w >> 48)); return r; }
template <int L>
__device__ __forceinline__ void postnorm_phase(const Args& a, LAS unsigned char* lds, int bid, int G, int tid, int wave, int lane) {
    const float* mod = (const float*)(a.ws + WS_MOD) + (size_t)L * 32 * 3072; const bf16* O = (const bf16*)(a.ws + WS_O); bf16* H = (bf16*)(a.ws + WS_H);
    GateW gwt;
    if constexpr (L == 0) gl_load_w(gwt, (const bf16*)(a.ws + WS_WIN) + (size_t)NU * D, wave, lane);
    for (int blk = bid; blk < MROWS / 256; blk += G) {
        const int m0 = blk * 256 + wave * 32, b = m0 / SEQ;
        bf16* glt = (bf16*)att::ucol((const bf16*)(a.ws + WS_U), att::C_GL) + (size_t)blk * 256 * 64;
        f32x4 gp[4];
#pragma unroll
        for (int j = 0; j < 4; ++j) { const int k4 = lane + 64 * j; gp[j] = ((const f32x4*)(a.in[5] + (size_t)L * D))[k4] * ((const f32x4*)(mod + (size_t)b * 3072 + 2048))[k4]; }
        f32x4 g1s[4], sh1[4];
        if constexpr (L == 0) { const float* mod1 = (const float*)(a.ws + WS_MOD) + (size_t)32 * 3072 + (size_t)b * 3072;
#pragma unroll
            for (int j = 0; j < 4; ++j) { const int k4 = lane + 64 * j; const f32x4 g = ((const f32x4*)(a.in[4] + D))[k4]; const f32x4 sc = ((const f32x4*)(mod1 + 1024))[k4];
                g1s[j] = g * (sc + 1.f); sh1[j] = ((const f32x4*)mod1)[k4]; } }
        unsigned long long no[4], nb[4]; f32x4 nx[4];
        pn_load<L>(a, O, m0, lane, no, nx, nb);
        for (int s = 0; s < 16; ++s) {
#pragma unroll
            for (int e = 0; e < 2; ++e) {
                const int m = m0 + 2 * s + e;
                f32x4 o[4], x[4]; float ss = 0.f;
#pragma unroll
                for (int j = 0; j < 4; ++j) { o[j] = unpack4(no[j]); if constexpr (L == 0) x[j] = nx[j]; else x[j] = unpack4(nb[j]); }
                if (2 * s + e + 1 < 32) pn_load<L>(a, O, m + 1, lane, no, nx, nb);
#pragma unroll
                for (int j = 0; j < 4; ++j) ss += (o[j].x * o[j].x + o[j].y * o[j].y) + (o[j].z * o[j].z + o[j].w * o[j].w);
                const float rstd = 1.f / sqrtf(wave_sum(ss) * (1.f / D) + RMS_EPS);
                float s2 = 0.f;
#pragma unroll
                for (int j = 0; j < 4; ++j) { x[j] = x[j] + o[j] * rstd * gp[j]; s2 += (x[j].x * x[j].x + x[j].y * x[j].y) + (x[j].z * x[j].z + x[j].w * x[j].w); }
                if constexpr (L == 0) {
                    store_bf16_row((bf16*)((char*)a.out + (size_t)m * (D * 4)), lane, x);
                    const float rstd2 = 1.f / sqrtf(wave_sum(s2) * (1.f / D) + RMS_EPS);
#pragma unroll
                    for (int j = 0; j < 4; ++j) x[j] = x[j] * rstd2 * g1s[j] + sh1[j];
                    { unsigned long long w[4]; pack_row(x, w); store_row_w(H + (size_t)m * D, lane, w); gl_put_row_w(lds, s & 1, 2 * wave + e, lane, w); }
                } else {
                    f32x4* outr = (f32x4*)(a.out + (size_t)m * D) + lane;
#pragma unroll
                    for (int j = 0; j < 4; ++j) outr[64 * j] = x[j];
                }
            }
            if constexpr (L == 0) {
                __syncthreads();
                gl_partial(lds, s & 1, wave, lane, gwt);
                if (s > 0) gl_reduce(lds, s - 1, tid, glt);
            }
        }
        if constexpr (L == 0) {
            __syncthreads();
            gl_reduce(lds, 15, tid, glt);
            __syncthreads();
        }
    }
}

__device__ __forceinline__ float gelu_tanh(float x) {
    const float z = 0.7978845608028654f * (x + 0.044715f * x * x * x);
    const float e = __expf(2.f * z);
    const float t = 1.f - 2.f / (1.f + e);
    return 0.5f * x * (1.f + t);
}
__device__ __forceinline__ void kmean_compress_phase(const Args& a, int l, LAS unsigned char* lds, int bid, int G, int tid, int wave, int lane) {
    const bf16* U = (const bf16*)(a.ws + WS_U);
    const float* KA = (const float*)(a.ws + WS_KMACC) + (size_t)l * 131072;
    auto km_put = [&](int i, float sum) {
        const int cc = i & 63, n = (i >> 6) & 7, bh = i >> 9;
        const float mean = sum * (1.f / 256.f);
        const unsigned hi = f2bf(mean); const float lo = mean - __uint_as_float(hi << 16);
        bf16* KM = (bf16*)(a.ws + WS_KMHL) + (size_t)(bh * 16) * 64;
        KM[n * 64 + cc] = (bf16)hi; KM[(8 + n) * 64 + cc] = (bf16)f2bf(lo); };
    const int km_i0 = bid * 512 + tid;
    float km_v0 = (km_i0 < 131072) ? KA[km_i0] : 0.f;
    bool km_pending = true;
    for (int base = bid * 4; base < 1024; base += G * 4) {
        const int item = base + (wave & 3), hk = wave >> 2;
        const int tt = item & 7, kv = (item >> 3) & 1, g = (item >> 4) & 1, b = item >> 5;
        const int tt0 = base & 7;
        const int fr = lane & 15, fq = lane >> 4;
        f32x4 acc[4];
        {
            const int nblk = (tt0 == 4) ? 128 : 130;
            const char* ublk = (const char*)(att::ucol(U, (kv ? att::C_VC : att::C_KC) + g * 64) + ((size_t)b * SEQ + 256 * tt0) * 64);
            const unsigned lds0 = (unsigned)(uintptr_t)lds;
            for (int j = wave; j < nblk; j += 8)
                att::glds16(ublk + j * 1024 + ((lane ^ ((j >> 1) & 15)) << 4), (unsigned)__builtin_amdgcn_readfirstlane((int)(lds0 + j * 1024)));
            const bf16* W1 = (const bf16*)(a.ws + WS_WC1) + (size_t)(l * 2 + kv) * 64 * 2048 + (size_t)fr * 2048 + 8 * fq + 4 * wave * 64;
            bf16x8 bw[4][8];
#pragma unroll
            for (int nt = 0; nt < 4; ++nt)
#pragma unroll
                for (int ks = 0; ks < 8; ++ks) bw[nt][ks] = *(const bf16x8*)(W1 + (size_t)nt * 16 * 2048 + ks * 32);
            if (km_pending) { km_pending = false; if (km_i0 < 131072) km_put(km_i0, km_v0);
                for (int i = km_i0 + G * 512; i < 131072; i += G * 512) km_put(i, KA[i]); }
            asm volatile("s_waitcnt vmcnt(0)" ::: "memory");
            __syncthreads();
            f32x4 pa[4][4];
#pragma unroll
            for (int mt = 0; mt < 4; ++mt)
#pragma unroll
                for (int nt = 0; nt < 4; ++nt) pa[mt][nt] = (f32x4){0.f, 0.f, 0.f, 0.f};
#pragma unroll
            for (int ks = 0; ks < 8; ++ks) {
                const int li = 4 * wave + (ks >> 1), kk = ks & 1;
#pragma unroll
                for (int mt = 0; mt < 4; ++mt) {
                    int tl = 16 * mt + fr; if (16 * tt0 + tl > 126) tl = 126 - 16 * tt0;
                    const int rel = 16 * tl + li, blk = rel >> 3;
                    const bf16x8 af = *(const LAS bf16x8*)(lds + blk * 1024 + (((((rel & 7) << 3) + kk * 4 + fq) ^ ((blk >> 1) & 15)) << 4));
#pragma unroll
                    for (int nt = 0; nt < 4; ++nt) pa[mt][nt] = __builtin_amdgcn_mfma_f32_16x16x32_bf16(af, bw[nt][ks], pa[mt][nt], 0, 0, 0);
                }
            }
            __syncthreads();
            LAS float* xw = (LAS float*)lds + wave * 4096 + lane;
#pragma unroll
            for (int mt = 0; mt < 4; ++mt)
#pragma unroll
                for (int nt = 0; nt < 4; ++nt)
#pragma unroll
                    for (int r = 0; r < 4; ++r) xw[(mt * 16 + nt * 4 + r) * 64] = pa[mt][nt][r];
        }
        __syncthreads();
        if (hk == 0 && item < 1024) {
            const bf16* W2 = (const bf16*)(a.ws + WS_WC2) + (size_t)(l * 2 + kv) * 64 * 64 + (size_t)fr * 64 + 8 * fq;
            bf16x8 w2v[2][4];
#pragma unroll
            for (int kk = 0; kk < 2; ++kk)
#pragma unroll
                for (int nt = 0; nt < 4; ++nt) w2v[kk][nt] = *(const bf16x8*)(W2 + (size_t)nt * 16 * 64 + kk * 32);
#pragma unroll
            for (int nt = 0; nt < 4; ++nt)
#pragma unroll
                for (int r = 0; r < 4; ++r) { const LAS float* xr = (const LAS float*)lds + (wave * 16 + nt * 4 + r) * 64 + lane; float sm = 0.f;
#pragma unroll
                    for (int w8 = 0; w8 < 8; ++w8) sm += xr[w8 * 4096];
                    acc[nt][r] = sm; }
            LAS bf16* hs = (LAS bf16*)(lds + 131072 + wave * 4096);
            const float* pec = (const float*)(a.ws + WS_PEC) + (l * 2 + kv) * 64;
#pragma unroll
            for (int nt = 0; nt < 4; ++nt) { const float pc = pec[16 * nt + fr];
#pragma unroll
                for (int r = 0; r < 4; ++r) hs[(4 * fq + r) * 72 + 16 * nt + fr] = (bf16)f2bf(gelu_tanh(acc[nt][r] + pc)); }
            asm volatile("s_waitcnt lgkmcnt(0)" ::: "memory");
            f32x4 acc2[4];
#pragma unroll
            for (int nt = 0; nt < 4; ++nt) acc2[nt] = (f32x4){0.f, 0.f, 0.f, 0.f};
#pragma unroll
            for (int kk = 0; kk < 2; ++kk) { const bf16x8 af = *(const LAS bf16x8*)(hs + fr * 72 + kk * 32 + 8 * fq);
#pragma unroll
                for (int nt = 0; nt < 4; ++nt) acc2[nt] = __builtin_amdgcn_mfma_f32_16x16x32_bf16(af, w2v[kk][nt], acc2[nt], 0, 0, 0); }
            bf16* dst = (bf16*)(a.ws + (kv ? WS_VC : WS_KC)) + (size_t)((b * 2 + g) * 128) * 64;
#pragma unroll
            for (int nt = 0; nt < 4; ++nt)
#pragma unroll
                for (int r = 0; r < 4; ++r) { const int trow = tt * 16 + 4 * fq + r; dst[trow * 64 + 16 * nt + fr] = (trow < 127) ? (bf16)f2bf(acc2[nt][r]) : (bf16)0; }
            asm volatile("s_waitcnt lgkmcnt(0)" ::: "memory");
        }
        __syncthreads();
    }
}

#ifndef REP_ATT
#define REP_ATT 1
#endif
#ifndef REP_GEMM
#define REP_GEMM 1
#endif
#ifndef REP_ROW
#define REP_ROW 1
#endif
#ifndef REP_KC
#define REP_KC 1
#endif
__global__ void __launch_bounds__(NWAVES * 64, 2) hybrid_fwd(Args args) {
    extern __shared__ __attribute__((aligned(16))) unsigned char lds[];
    cg::grid_group grid = cg::this_grid();
    LAS unsigned char* L = (LAS unsigned char*)lds;
    const int wave = __builtin_amdgcn_readfirstlane(threadIdx.x >> 6);
    const int G = gridDim.x, bid = blockIdx.x;
    unsigned char* ws = args.ws;
    const int gw = bid * NWAVES + wave;
    volatile LAS unsigned* MISC = (volatile LAS unsigned*)(L + LDS_MISC);
    if (threadIdx.x < 32) MISC[threadIdx.x] = 0u;
    __syncthreads();
    XcdBarrier bar = xcd_barrier_post((unsigned*)(ws + WS_CTL) + CW_BAR, MISC + 8);
    if (threadIdx.x == 0) { const unsigned x = xb_xcc_id(); MISC[16] = x; MISC[17] = atomicAdd((unsigned*)(ws + WS_CTL) + CW_XR + 64 * x, 1u); }
#define GRID_BAR() do { XcdBarrier b_ = bar; asm volatile("" : "+s"(b_.bar), "+s"(b_.x)); xcd_barrier(b_, wave == 0 && lane_id() == 0); } while (0)
#define OPAQUE_TID(t) int t = wave * 64 + lane_id(); asm volatile("" : "+v"(t))
#ifndef REP_PRO
#define REP_PRO 1
#endif
    for (int rep = 0; rep < REP_PRO; ++rep) { OPAQUE_TID(tid); p0_prologue(args, L, bid, G, tid, wave, tid & 63); __syncthreads(); }
    if (args.cg_seam) grid.sync(); else GRID_BAR();
    if (threadIdx.x == 0) { bool ok = (G == 256); for (int x = 0; x < 8; ++x) ok = ok && (xb_ld((unsigned*)(ws + WS_CTL) + CW_XR + 64 * x) == 32u);
        MISC[18] = ok ? MISC[16] * 32u + MISC[17] : 0xffffffffu; }
    __syncthreads();
    const int vcu = (int)__builtin_amdgcn_readfirstlane((int)MISC[18]);
    const bool grouped = (G == 256);
    const int v = (vcu >= 0) ? vcu : bid;
    unsigned gep = 0u;
#define SEAM() do { if (grouped) { ++gep; unsigned* c_ = (unsigned*)(ws + WS_CTL) + CW_GRP + 64 * (v >> 3); unsigned* b_ = (unsigned*)(ws + WS_CTL) + CW_BAR; asm volatile("" : "+s"(c_), "+s"(b_)); \
        group_barrier(b_, c_, 8u * gep, vcu >= 0, wave == 0 && lane_id() == 0); } else GRID_BAR(); } while (0)
    const int pb = grouped ? v : bid, pG = grouped ? 256 : G;
    for (int rep = 0; rep < REP_ROW; ++rep) { OPAQUE_TID(tid); prenorm0_phase(args, L, pb, pG, tid, wave, tid & 63); }
    SEAM();
    for (int l = 0; l < DEPTH; ++l) {
        for (int rep = 0; rep < REP_GEMM; ++rep) {
            OPAQUE_TID(tid);
            pg8::Gemm g{(const pg8::bf16_t*)(ws + WS_H), (const pg8::bf16_t*)(ws + WS_WIN) + (size_t)l * NU * D, MROWS, N_G1, D};
            pg8::EpiStoreGK E{(pg8::bf16_t*)(ws + WS_U), MROWS, D_IN, (float*)(ws + WS_KMACC) + (size_t)l * 131072};
            if (grouped) { pg8::GroupOrder<N_G1 / 256> S; S.init(v >> 3, v & 7); pg8::gemm_phase<pg8::EpiStoreGK, pg8::GroupOrder<N_G1 / 256>, true, true>(L, g, S, E, tid); }
            else { pg8::StaticOrder S; S.init(MROWS, N_G1, G, bid); pg8::gemm_phase<pg8::EpiStoreGK, pg8::StaticOrder, true, true>(L, g, S, E, tid); }
        }
        SEAM();
        for (int rep = 0; rep < REP_KC; ++rep) { OPAQUE_TID(tid); kmean_compress_phase(args, l, L, pb, pG, tid, wave, tid & 63); }
        SEAM();
        for (int rep = 0; rep < REP_ATT; ++rep)
        att::attn_phase((char*)lds, (const att::bf16_t*)(ws + WS_U), (const att::bf16_t*)(ws + WS_KMHL), (const att::bf16_t*)(ws + WS_KC), (att::bf16_t*)(ws + WS_Y), vcu, wave);
        SEAM();
        for (int rep = 0; rep < REP_GEMM; ++rep) {
            OPAQUE_TID(tid);
            pg8::Gemm g{(const pg8::bf16_t*)(ws + WS_Y), (const pg8::bf16_t*)(ws + WS_WOUT) + (size_t)l * D * D, MROWS, D, D};
            pg8::EpiStore E{(pg8::bf16_t*)(ws + WS_O), D, D};
            if (grouped) { pg8::OwnerOrder<D / 256> S; S.init(v >> 3, v & 7); pg8::gemm_phase<pg8::EpiStore, pg8::OwnerOrder<D / 256>, true, true>(L, g, S, E, tid); }
            else { pg8::StaticOrder S; S.init(MROWS, D, G, bid); pg8::gemm_phase<pg8::EpiStore, pg8::StaticOrder, true, true>(L, g, S, E, tid); }
        }
        if (grouped) { asm volatile("s_waitcnt vmcnt(0)" ::: "memory"); __syncthreads(); __builtin_amdgcn_fence(__ATOMIC_ACQUIRE, "agent"); } else GRID_BAR();
        for (int rep = 0; rep < (l == 0 ? REP_ROW : 1); ++rep) { OPAQUE_TID(tid); if (l == 0) postnorm_phase<0>(args, L, pb, pG, tid, wave, tid & 63); else postnorm_phase<1>(args, L, pb, pG, tid, wave, tid & 63); }
        if (l + 1 < DEPTH) SEAM();
    }
#undef SEAM
#undef OPAQUE_TID
#undef GRID_BAR
}

extern "C" void kernel_launch(void* const* d_in, const int* in_sizes, int n_in, void* d_out, int out_size, void* d_ws, size_t ws_size, hipStream_t stream) {
    static int grid = 0;
    if (grid == 0) {
        if (n_in != 14 || out_size != MROWS * D || ws_size < WS_END) { fprintf(stderr, "kernel_launch: unexpected shapes (n_in %d, out %d, ws %zu)\n", n_in, out_size, ws_size); grid = -1; return; }
        int dev = 0, cus = 0, per_cu = 0;
        hipGetDevice(&dev); hipDeviceGetAttribute(&cus, hipDeviceAttributeMultiprocessorCount, dev);
        if (hipFuncSetAttribute((const void*)hybrid_fwd, hipFuncAttributeMaxDynamicSharedMemorySize, LDS_BYTES) != hipSuccess) { fprintf(stderr, "kernel_launch: hipFuncSetAttribute failed\n"); grid = -1; return; }
        if (hipOccupancyMaxActiveBlocksPerMultiprocessor(&per_cu, (const void*)hybrid_fwd, NWAVES * 64, LDS_BYTES) != hipSuccess || per_cu < 1) { fprintf(stderr, "kernel_launch: occupancy query says %d blocks per CU\n", per_cu); per_cu = 1; }
        (void)hipGetLastError();
        grid = cus;
    }
    if (grid < 0) return;
    hipMemsetAsync((char*)d_ws + WS_CTL, 0, CTL_ZERO_BYTES, stream);
    Args a{};
    for (int i = 0; i < 14; ++i) a.in[i] = (const float*)d_in[i];
    a.out = (float*)d_out; a.ws = (unsigned char*)d_ws;
    void* kargs[] = {&a};
    hipError_t e = hipLaunchCooperativeKernel((const void*)hybrid_fwd, dim3(grid), dim3(NWAVES * 64), kargs, LDS_BYTES, stream);
    if (e != hipSuccess) fprintf(stderr, "kernel_launch: cooperative launch failed: %s (grid %d)\n", hipGetErrorString(e), grid);
}
```
